# Optimizing an MI355X kernel written in HIP

```python
import jax, jax.numpy as jnp
from jax import lax
import numpy as np

D_MODEL = 1024
BATCH = 16
SEQ = 256
DEPTH = 2
DEC_BATCH = 8
DEC_SEQ = 4096
PAST_LEN = 512

GRID_W = 64
N_HEADS = 8
KV_HEADS = 2
HEAD_DIM = 64
Q_PER_KV = N_HEADS // KV_HEADS
ATT_W = N_HEADS * HEAD_DIM
KV_W = KV_HEADS * HEAD_DIM
WINDOW = 128
BLOCK = 128
CONV_W = D_MODEL // 2
CONV_K = 3
FOU_GROUPS = 4
FOU_GW = 128
FOU_W = FOU_GROUPS * FOU_GW
BRANCH_W = 512
N_BRANCH = 3
ROT_AXIS = HEAD_DIM // 2
ROPE_BASE = 10000.0
LN_EPS = 1e-6
NEG = -1e30
DEEPNORM_ALPHA = (2 * DEPTH) ** 0.25
DEEPNORM_BETA = (8 * DEPTH) ** -0.25
IN_SPLITS = (ATT_W, KV_W, KV_W, ATT_W, CONV_W, CONV_W, CONV_W, CONV_W, FOU_W, FOU_W, N_BRANCH * D_MODEL)
IN_W = 2 * ATT_W + 2 * KV_W + 4 * CONV_W + 2 * FOU_W + N_BRANCH * D_MODEL

kernel_name = "hybrid_diffusion_gated_branches_step"


def _layernorm(x):
    xf = x.astype(jnp.float32)
    mu = jnp.mean(xf, axis=-1, keepdims=True)
    var = jnp.mean(jnp.square(xf - mu), axis=-1, keepdims=True)
    return (xf - mu) * lax.rsqrt(var + LN_EPS)


def _modulation(cond, w_mod_l, b_mod_l):
    m = jax.nn.silu(cond) @ w_mod_l + b_mod_l
    shift, scale, gate = jnp.split(m, 3, axis=-1)
    return shift[:, None, :], scale[:, None, :], gate[:, None, :]


def _grid_angles(n_tokens):
    rows = n_tokens // GRID_W
    row = jnp.repeat(jnp.arange(rows, dtype=jnp.int32), GRID_W).astype(jnp.float32)
    col = jnp.tile(jnp.arange(GRID_W, dtype=jnp.int32), rows).astype(jnp.float32)
    n_freq = ROT_AXIS // 2
    inv_freq = ROPE_BASE ** (-jnp.arange(n_freq, dtype=jnp.float32) / n_freq)
    return row[:, None] * inv_freq, col[:, None] * inv_freq


def _rotate(seg, ang):
    x1, x2 = jnp.split(seg, 2, axis=-1)
    shape = (1, seg.shape[1]) + (1,) * (seg.ndim - 3) + (ang.shape[-1],)
    cos = jnp.cos(ang).reshape(shape).astype(seg.dtype)
    sin = jnp.sin(ang).reshape(shape).astype(seg.dtype)
    return jnp.concatenate([x1 * cos - x2 * sin, x2 * cos + x1 * sin], axis=-1)


def _rope2d(x, ang_r, ang_c):
    return jnp.concatenate([_rotate(x[..., :ROT_AXIS], ang_r), _rotate(x[..., ROT_AXIS:], ang_c)], axis=-1)


def _softmax_with_sink(logits, sink_l):
    sink = jnp.broadcast_to(sink_l.astype(jnp.float32).reshape(1, KV_HEADS, Q_PER_KV, 1, 1),
                            logits.shape[:-1] + (1,))
    p = jax.nn.softmax(jnp.concatenate([logits, sink], axis=-1), axis=-1)
    return p[..., :-1]


def _attend_context(q, k, v, sink_l):
    b, s = q.shape[:2]
    logits = jnp.einsum('bqkgd,bckd->bkgqc', q, k).astype(jnp.float32) * (HEAD_DIM ** -0.5)
    p = _softmax_with_sink(logits, sink_l).astype(v.dtype)
    out = jnp.einsum('bkgqc,bckd->bqkgd', p, v)
    return out.reshape(b, s, ATT_W)


def _attend_latent(q, k, v, k_ctx, v_ctx, sink_l):
    b, s = q.shape[:2]
    nb = s // BLOCK
    pad = ((0, 0), (BLOCK, BLOCK), (0, 0), (0, 0))
    kp = jnp.pad(k, pad)
    vp = jnp.pad(v, pad)
    scale = HEAD_DIM ** -0.5

    def block(i):
        start = i * BLOCK
        qb = lax.dynamic_slice_in_dim(q, start, BLOCK, axis=1)
        kb = lax.dynamic_slice_in_dim(kp, start, 3 * BLOCK, axis=1)
        vb = lax.dynamic_slice_in_dim(vp, start, 3 * BLOCK, axis=1)
        s_loc = jnp.einsum('bqkgd,bjkd->bkgqj', qb, kb).astype(jnp.float32) * scale
        tq = start + jnp.arange(BLOCK)
        tk = start - BLOCK + jnp.arange(3 * BLOCK)
        valid = (tk[None, :] >= 0) & (tk[None, :] < s) & (jnp.abs(tq[:, None] - tk[None, :]) <= WINDOW)
        s_loc = jnp.where(valid, s_loc, NEG)
        s_ctx = jnp.einsum('bqkgd,bckd->bkgqc', qb, k_ctx).astype(jnp.float32) * scale
        p = _softmax_with_sink(jnp.concatenate([s_loc, s_ctx], axis=-1), sink_l).astype(v.dtype)
        return (jnp.einsum('bkgqj,bjkd->bqkgd', p[..., :3 * BLOCK], vb)
                + jnp.einsum('bkgqc,bckd->bqkgd', p[..., 3 * BLOCK:], v_ctx))

    outs = lax.map(block, jnp.arange(nb))
    return jnp.moveaxis(outs, 0, 1).reshape(b, s, ATT_W)


def _short_conv(b_gate, c_gate, xin, conv_w_l):
    u = c_gate * xin
    s = u.shape[1]
    up = jnp.pad(u, ((0, 0), (1, 1), (0, 0)))
    y = up[:, 0:s] * conv_w_l[0] + up[:, 1:s + 1] * conv_w_l[1] + up[:, 2:s + 2] * conv_w_l[2]
    return b_gate * y


def _fourier(f):
    b, s, _ = f.shape
    g = f.reshape(b, s, FOU_GROUPS, FOU_GW).astype(jnp.float32)
    y = jnp.fft.fft2(g, axes=(1, 3), norm='ortho').real
    return y.astype(f.dtype).reshape(b, s, FOU_W)


def _layer(x, shift, scale, gate, w_in_l, conv_w_l, w_branch_l, w_o_l, ln_g_l, ln_b_l, attn_fn):
    b, s, _ = x.shape
    h = (_layernorm(x) * (1.0 + scale) + shift).astype(x.dtype)
    offsets = np.cumsum(IN_SPLITS)[:-1].tolist()
    q, k, v, z_a, cb, cc, cx, z_b, fx, z_c, g = jnp.split(h @ w_in_l, offsets, axis=-1)
    q = q.reshape(b, s, KV_HEADS, Q_PER_KV, HEAD_DIM)
    k = k.reshape(b, s, KV_HEADS, HEAD_DIM)
    v = v.reshape(b, s, KV_HEADS, HEAD_DIM)
    y_a = attn_fn(q, k, v) * jax.nn.silu(z_a)
    y_b = _short_conv(cb, cc, cx, conv_w_l) * jax.nn.silu(z_b)
    y_c = _fourier(fx) * jax.nn.silu(z_c)
    gates = jax.nn.sigmoid(g.reshape(b, s, N_BRANCH, D_MODEL))
    merged = (gates[:, :, 0] * (y_a @ w_branch_l[0])
              + gates[:, :, 1] * (y_b @ w_branch_l[1])
              + gates[:, :, 2] * (y_c @ w_branch_l[2]))
    out = merged @ w_o_l
    r = _layernorm(DEEPNORM_ALPHA * x + gate * out) * ln_g_l + ln_b_l
    return r.astype(x.dtype), k, v


def setup_inputs(seed: int = 0) -> dict:
    key = jax.random.key(seed)
    ks = jax.random.split(key, 16)
    nrm = jax.random.normal
    f32 = jnp.float32
    return {
        'x_prompt': nrm(ks[0], (BATCH, SEQ, D_MODEL), f32),
        'x_sample': nrm(ks[1], (DEC_BATCH, DEC_SEQ, D_MODEL), f32),
        'cache_k': nrm(ks[2], (DEC_BATCH, DEPTH, PAST_LEN, KV_HEADS, HEAD_DIM), f32),
        'cache_v': nrm(ks[3], (DEC_BATCH, DEPTH, PAST_LEN, KV_HEADS, HEAD_DIM), f32),
        'c': nrm(ks[4], (DEC_BATCH, D_MODEL), f32),
        'c_ctx': nrm(ks[5], (D_MODEL,), f32),
        'w_mod': nrm(ks[6], (DEPTH, D_MODEL, 3 * D_MODEL), f32) * D_MODEL ** -0.5,
        'b_mod': 0.01 * nrm(ks[7], (DEPTH, 3 * D_MODEL), f32),
        'w_in': nrm(ks[8], (DEPTH, D_MODEL, IN_W), f32) * D_MODEL ** -0.5,
        'sink': 0.5 * nrm(ks[9], (DEPTH, N_HEADS), f32),
        'conv_w': nrm(ks[10], (DEPTH, CONV_K, CONV_W), f32) * CONV_K ** -0.5,
        'w_branch': nrm(ks[11], (DEPTH, N_BRANCH, BRANCH_W, D_MODEL), f32) * (BRANCH_W ** -0.5 * DEEPNORM_BETA),
        'w_o': nrm(ks[12], (DEPTH, D_MODEL, D_MODEL), f32) * (D_MODEL ** -0.5 * DEEPNORM_BETA),
        'ln_g': 1.0 + 0.01 * nrm(ks[13], (DEPTH, D_MODEL), f32),
        'ln_b': 0.01 * nrm(ks[14], (DEPTH, D_MODEL), f32),
    }


def reference(x_prompt, x_sample, cache_k, cache_v, c, c_ctx, w_mod, b_mod, w_in, sink, conv_w,
              w_branch, w_o, ln_g, ln_b):
    y_prompt = x_prompt
    k_list, v_list = [], []
    for l in range(DEPTH):
        shift, scale, gate = _modulation(c_ctx[None, :], w_mod[l], b_mod[l])
        attn = lambda q, k, v, l=l: _attend_context(q, k, v, sink[l])
        y_prompt, k_l, v_l = _layer(y_prompt, shift, scale, gate, w_in[l], conv_w[l], w_branch[l],
                                    w_o[l], ln_g[l], ln_b[l], attn)
        k_list.append(k_l)
        v_list.append(v_l)
    new_k = jnp.stack(k_list, axis=1)
    new_v = jnp.stack(v_list, axis=1)

    y_sample = x_sample
    ang_r, ang_c = _grid_angles(x_sample.shape[1])
    for l in range(DEPTH):
        shift, scale, gate = _modulation(c, w_mod[l], b_mod[l])
        attn = lambda q, k, v, l=l: _attend_latent(_rope2d(q, ang_r, ang_c), _rope2d(k, ang_r, ang_c), v,
                                                   cache_k[:, l], cache_v[:, l], sink[l])
        y_sample, _, _ = _layer(y_sample, shift, scale, gate, w_in[l], conv_w[l], w_branch[l],
                                w_o[l], ln_g[l], ln_b[l], attn)

    return (y_prompt, y_sample, new_k, new_v)
```

```cpp
#include <hip/hip_runtime.h>
#include <hip/hip_cooperative_groups.h>
#include <cstdio>
#include <cstdint>
namespace cg = cooperative_groups;


#ifndef MK_MULTI
#define MK_MULTI 0
#endif

#define LAS __attribute__((address_space(3)))
typedef unsigned short bf16_t;
typedef short bf16x8 __attribute__((ext_vector_type(8)));
typedef short s16x4 __attribute__((ext_vector_type(4)));
typedef float f32x4 __attribute__((ext_vector_type(4)));
typedef unsigned u32x4 __attribute__((ext_vector_type(4)));
typedef unsigned u32x2 __attribute__((ext_vector_type(2)));

constexpr int DM = 1024, TP = 4096, TS = 32768, TT = TP + TS;
constexpr int INW = 7424;
constexpr int NT1 = 19;
constexpr size_t MiB = 1u << 20;
constexpr size_t WS_MOD = 0, WS_FMAT = 1 * MiB, WS_BT1 = 2 * MiB, WS_BT1G = 21 * MiB, WS_BT2AC = 33 * MiB, WS_BT2B = 37 * MiB, WS_BT3 = 41 * MiB,
                 WS_CK = 45 * MiB, WS_CV = 47 * MiB, WS_H = 49 * MiB  , WS_MG = WS_H,
                 WS_Q = 121 * MiB  , WS_KV = 157 * MiB, WS_BUF1 = 193 * MiB,
                 WS_BUF2 = 265 * MiB, WS_Z = 337 * MiB  , WS_GT2 = 409 * MiB, WS_END = 481 * MiB;
constexpr size_t WS_BAR = 512 * 1024;
constexpr size_t WS_CNT = WS_BAR + 16384;
constexpr size_t WS_CNT2 = WS_BAR + 18432;
constexpr size_t BT1_L = (size_t)NT1 * 256 * 1024 * 2, BT1G_L = (size_t)3072 * 1024 * 2, BT2_L = (size_t)1024 * 1024 * 2;
constexpr int LDS_BYTES = 147456;
constexpr int NPHASE = 10;
constexpr size_t OUT_NK = (size_t)TT * DM, OUT_NV = OUT_NK + (size_t)16 * 2 * 256 * 128;

struct Args {
    const float *x_prompt, *x_sample, *cache_k, *cache_v, *c, *c_ctx, *w_mod, *b_mod, *w_in, *sink, *conv_w, *w_branch, *w_o, *ln_g, *ln_b;
    float* out; unsigned char* ws; int ph_lo, ph_hi;
};

__device__ __forceinline__ float bflo(unsigned w) { return __uint_as_float(w << 16); }
__device__ __forceinline__ float bfhi(unsigned w) { return __uint_as_float(w & 0xffff0000u); }
__device__ __forceinline__ float bf1(unsigned short h) { return __uint_as_float((unsigned)h << 16); }
__device__ __forceinline__ unsigned f2bf(float f) { unsigned u = __float_as_uint(f); return (u + 0x7fffu + ((u >> 16) & 1u)) >> 16; }
__device__ __forceinline__ unsigned pk2(float lo, float hi) { return f2bf(lo) | (f2bf(hi) << 16); }
typedef float f32x2_t __attribute__((ext_vector_type(2))); typedef __bf16 bf16x2_t __attribute__((ext_vector_type(2)));
__device__ __forceinline__ unsigned cvt_pk(float lo, float hi) { f32x2_t v = {lo, hi}; bf16x2_t b = __builtin_convertvector(v, bf16x2_t); return __builtin_bit_cast(unsigned, b); }
__device__ __forceinline__ float silu_f(float x) { return x * __builtin_amdgcn_rcpf(1.0f + __expf(-x)); }
__device__ __forceinline__ float sigm_f(float x) { return __builtin_amdgcn_rcpf(1.0f + __expf(-x)); }
__device__ __forceinline__ float wave_sum(float v) {
#pragma unroll
    for (int o = 1; o < 64; o <<= 1) v += __shfl_xor(v, o);
    return v;
}
__device__ __forceinline__ int cond_of_row(int m) { return m < TP ? 0 : 1 + ((m - TP) >> 12); }

namespace pg8 {
constexpr int BM = 256, BK = 64, HALF = 128, HTB = HALF * BK * 2, STAGE_BYTES = 8 * HTB, KP = 1024;
constexpr size_t TSTEP = (size_t)BM * KP * 2;
__device__ __forceinline__ int lds_byte(int r, int c) { const int st = (r >> 4) * 2 + (c >> 5), rr = r & 15, cc = c & 31, ob = rr * 64 + cc * 2; return st * 1024 + (ob ^ (((ob >> 9) & 1) << 5)); }
__device__ __forceinline__ void stage_rc(int b, int& R, int& C) { const int st = b / 1024, sb = b % 1024, swz = sb ^ (((sb >> 9) & 1) << 5); R = (st >> 1) * 16 + swz / 64; C = (st & 1) * 32 + (swz % 64) / 2; }

struct Unit { int pm, pn, kind, nt; const char* a; const char* b; };

template <class Epi, class Sched>
__device__ __forceinline__ void gemm_phase(LAS unsigned char* lds, const Sched& S, const Epi& E) {
    int tid = threadIdx.x; asm volatile("" : "+v"(tid));
    const int wid = __builtin_amdgcn_readfirstlane(tid >> 6), lane = tid & 63, wr = wid >> 2, wc = wid & 3, fr = lane & 15, fq = lane >> 4;
    unsigned voff[2];
#pragma unroll
    for (int i = 0; i < 2; ++i) { int R, C; stage_rc(tid * 16 + i * 8192, R, C); voff[i] = (unsigned)(R * KP + C) * 2u; }
    constexpr size_t kstep = (size_t)(BK * 2);
    constexpr size_t hstep = (size_t)HALF * KP * 2;
    const unsigned ldsw = (unsigned)wid * 1024u;
    const int aoff = lds_byte(wr * 64 + fr, fq * 8), boff = lds_byte(wc * 32 + fr, fq * 8);
#define PG8_SA(b, h) (((b) * 2 + (h)) * HTB)
#define PG8_SB(b, h) ((4 + (b) * 2 + (h)) * HTB)
#define PG8_STAGE(bufoff, gbase) do { _Pragma("unroll") for (int _i = 0; _i < 2; ++_i) \
        __builtin_amdgcn_global_load_lds((const unsigned*)((const char*)(gbase) + voff[_i]), (LAS unsigned*)(lds + (bufoff) + ldsw + _i * 8192), 16, 0, 0); } while (0)
#define PG8_LDA(dst, b, h) do { _Pragma("unroll") for (int m = 0; m < 4; ++m) _Pragma("unroll") for (int k = 0; k < 2; ++k) dst[m][k] = *(const LAS bf16x8*)(lds + PG8_SA(b, h) + aoff + m * 2048 + k * 1024); } while (0)
#define PG8_LDB(dst, b, h) do { _Pragma("unroll") for (int n = 0; n < 2; ++n) _Pragma("unroll") for (int k = 0; k < 2; ++k) dst[n][k] = *(const LAS bf16x8*)(lds + PG8_SB(b, h) + boff + n * 2048 + k * 1024); } while (0)
#define PG8_MMA(ai, bj, At, Bt) do { __builtin_amdgcn_s_setprio(1); _Pragma("unroll") for (int m = 0; m < 4; ++m) _Pragma("unroll") for (int n = 0; n < 2; ++n) _Pragma("unroll") for (int k = 0; k < 2; ++k) \
        acc[ai][bj][m][n] = __builtin_amdgcn_mfma_f32_16x16x32_bf16(Bt[n][k], At[m][k], acc[ai][bj][m][n], 0, 0, 0); __builtin_amdgcn_s_setprio(0); } while (0)
#define PG8_WAIT_V(n) asm volatile("s_waitcnt vmcnt(" #n ")" ::: "memory")
#define PG8_WAIT_L(n) asm volatile("s_waitcnt lgkmcnt(" #n ")" ::: "memory")
#define PG8_BAR __builtin_amdgcn_s_barrier()
#define PG8_SCHED __builtin_amdgcn_sched_barrier(0)
    Unit cur, nxt; int ui = 0;
    if (!S.next(0, cur)) return;
    f32x4 acc[2][2][4][2];
#pragma unroll
    for (int a = 0; a < 2; ++a)
#pragma unroll
        for (int b = 0; b < 2; ++b)
#pragma unroll
            for (int m = 0; m < 4; ++m)
#pragma unroll
                for (int n = 0; n < 2; ++n) acc[a][b][m][n] = (f32x4){0.f, 0.f, 0.f, 0.f};
    bf16x8 At[4][2], B0[2][2], B1[2][2];
    const char* cA = cur.a; const char* cB = cur.b;
    PG8_STAGE(PG8_SB(0, 0), cB); PG8_STAGE(PG8_SB(0, 1), cB + hstep); PG8_STAGE(PG8_SA(0, 0), cA); PG8_STAGE(PG8_SA(0, 1), cA + hstep);
    if (wr == 1) PG8_BAR;
    PG8_WAIT_V(2); PG8_BAR;
    PG8_STAGE(PG8_SB(1, 0), cB + kstep); PG8_STAGE(PG8_SA(1, 0), cA + kstep); PG8_STAGE(PG8_SB(1, 1), cB + hstep + kstep);
    PG8_WAIT_V(6); PG8_BAR;
    for (;;) {
        const bool has_next = S.next(ui + 1, nxt);
        const char* nA = has_next ? nxt.a : cA; const char* nB = has_next ? nxt.b : cB;
        const int nt = cur.nt;
        for (int t = 0; t < nt; t += 2) {
            const bool last = (t == nt - 2);
            const char* a1 = cA + (size_t)(t + 1) * kstep;
            const char* a2 = last ? nA : cA + (size_t)(t + 2) * kstep; const char* b2 = last ? nB : cB + (size_t)(t + 2) * kstep;
            const char* a3 = a2 + kstep; const char* b3 = b2 + kstep;
            if (last && has_next) S.a_ready(nxt);
            PG8_LDB(B0, 0, 0); PG8_LDB(B1, 0, 1); PG8_SCHED; PG8_LDA(At, 0, 0); PG8_STAGE(PG8_SA(1, 1), a1 + hstep);
            PG8_WAIT_V(8); PG8_WAIT_L(0); PG8_BAR; PG8_MMA(0, 0, At, B0); PG8_MMA(0, 1, At, B1); PG8_BAR; PG8_SCHED;
            PG8_LDA(At, 0, 1); PG8_STAGE(PG8_SB(0, 0), b2); PG8_STAGE(PG8_SB(0, 1), b2 + hstep); PG8_STAGE(PG8_SA(0, 0), a2);
            PG8_WAIT_V(8); PG8_WAIT_L(0); PG8_BAR; PG8_MMA(1, 0, At, B0); PG8_MMA(1, 1, At, B1); PG8_BAR; PG8_SCHED;
            PG8_LDB(B0, 1, 0); PG8_LDB(B1, 1, 1); PG8_SCHED; PG8_LDA(At, 1, 0); PG8_STAGE(PG8_SA(0, 1), a2 + hstep);
            PG8_WAIT_V(8); PG8_WAIT_L(0); PG8_BAR; PG8_MMA(0, 0, At, B0); PG8_MMA(0, 1, At, B1); PG8_BAR; PG8_SCHED;
            PG8_LDA(At, 1, 1); PG8_STAGE(PG8_SB(1, 0), b3); PG8_STAGE(PG8_SB(1, 1), b3 + hstep); PG8_STAGE(PG8_SA(1, 0), a3);
            PG8_WAIT_V(8); PG8_WAIT_L(0); PG8_BAR; PG8_MMA(1, 0, At, B0); PG8_MMA(1, 1, At, B1); PG8_BAR; PG8_SCHED;
        }
        if (wr == 0) PG8_BAR;
        E(acc, cur, wr, wc, fr, fq);
        if (!has_next) break;
#pragma unroll
        for (int a = 0; a < 2; ++a)
#pragma unroll
            for (int b = 0; b < 2; ++b)
#pragma unroll
                for (int m = 0; m < 4; ++m)
#pragma unroll
                    for (int n = 0; n < 2; ++n) acc[a][b][m][n] = (f32x4){0.f, 0.f, 0.f, 0.f};
        cur = nxt; cA = nA; cB = nB; ++ui;
        if (wr == 1) PG8_BAR;
    }
    PG8_WAIT_V(0);
    PG8_BAR;
#undef PG8_SA
#undef PG8_SB
#undef PG8_STAGE
#undef PG8_LDA
#undef PG8_LDB
#undef PG8_MMA
#undef PG8_WAIT_V
#undef PG8_WAIT_L
#undef PG8_BAR
#undef PG8_SCHED
}
}
using pg8::Unit;

enum { K_Q = 0, K_KV = 1, K_ZA = 2, K_CONV = 3, K_Z = 4, K_ZC = 5, K_GATE = 6, K_P = 7, K_OUT = 8 };
struct SchedG1 {
    const char* A; const char* B; int G, c;
    __device__ __forceinline__ void a_ready(const Unit&) const {}
    __device__ __forceinline__ bool next(int i, Unit& u) const {
        constexpr int nM = TT / 256, nN = NT1, nwg = nM * nN, NXCD = 8, WGM = 8;
        const long L = (long)i * G + c; if (L >= nwg) return false;
        int wgid = (int)L; { const int q = nwg / NXCD, r = nwg % NXCD, xcd = wgid % NXCD, off = wgid / NXCD; wgid = (xcd < r ? xcd * (q + 1) : r * (q + 1) + (xcd - r) * q) + off; }
        const int nig = WGM * nN, gid = wgid / nig, fm = gid * WGM, gsz = (nM - fm) < WGM ? (nM - fm) : WGM;
        const int pm = fm + ((wgid % nig) % gsz), pn = (wgid % nig) / gsz;
        u.pm = pm; u.pn = pn; u.nt = 16;
        u.kind = pn < 2 ? K_Q : pn == 2 ? K_KV : pn < 5 ? K_ZA : pn < 13 ? K_CONV : pn < 17 ? K_Z : K_ZC;
        u.a = A + (size_t)pm * pg8::TSTEP; u.b = B + (size_t)pn * pg8::TSTEP; return true;
    }
};
__device__ __forceinline__ bool tile_of(int j, int G, int c, int& pm, int& pn) {
    if (G != 256) { const int L = j * G + c; if (L >= 576) return false; pm = L >> 2; pn = L & 3; return true; }
    const int xcd = c & 7, slot = c >> 3;
    if (j < 2) { pm = j * 64 + xcd * 8 + (slot >> 2); pn = slot & 3; return true; }
    if (j == 2 && slot < 8) { pm = 128 + 2 * xcd + (slot >> 2); pn = slot & 3; return true; }
    return false;
}
struct SchedGate {
    const char* A; const char* B; int G, c;
    __device__ __forceinline__ void a_ready(const Unit&) const {}
    __device__ __forceinline__ bool next(int i, Unit& u) const {
        constexpr int nM = TT / 256, nN = 12, nwg = nM * nN, NXCD = 8, WGM = 8;
        const long L = (long)i * G + c; if (L >= nwg) return false;
        int wgid = (int)L; { const int q = nwg / NXCD, r = nwg % NXCD, xcd = wgid % NXCD, off = wgid / NXCD; wgid = (xcd < r ? xcd * (q + 1) : r * (q + 1) + (xcd - r) * q) + off; }
        const int nig = WGM * nN, gid = wgid / nig, fm = gid * WGM, gsz = (nM - fm) < WGM ? (nM - fm) : WGM;
        const int pm = fm + ((wgid % nig) % gsz), pn = (wgid % nig) / gsz;
        u.pm = pm; u.pn = pn; u.nt = 16; u.kind = K_GATE;
        u.a = A + (size_t)pm * pg8::TSTEP; u.b = B + (size_t)pn * pg8::TSTEP; return true;
    }
};
struct SchedP {
    const char *B1, *B2, *Wac, *Wb; int G, c;
    __device__ __forceinline__ void a_ready(const Unit&) const {}
    __device__ __forceinline__ bool next(int i, Unit& u) const {
        const int j = i / 3, b = i - 3 * j; int pm, pn;
        if (!tile_of(j, G, c, pm, pn)) return false;
        u.pm = pm; u.pn = pn | (b << 4); u.kind = K_P; u.nt = 8;
        u.a = (b == 1 ? B2 : B1) + (size_t)pm * pg8::TSTEP + (b == 2 ? 1024 : 0);
        u.b = (b == 1 ? Wb : Wac) + (size_t)pn * pg8::TSTEP + (b == 2 ? 1024 : 0);
        return true;
    }
};
struct SchedG3 {
    const char* A; const char* B; int G, c;
    __device__ __forceinline__ void a_ready(const Unit&) const {}
    __device__ __forceinline__ bool next(int i, Unit& u) const {
        int pm, pn; if (!tile_of(i, G, c, pm, pn)) return false;
        u.pm = pm; u.pn = pn; u.kind = K_OUT; u.nt = 16; u.a = A + (size_t)u.pm * pg8::TSTEP; u.b = B + (size_t)u.pn * pg8::TSTEP; return true;
    }
};

__device__ __forceinline__ void st4bf(bf16_t* p, float a, float b, float c, float d) { u32x2 w; w.x = cvt_pk(a, b); w.y = cvt_pk(c, d); *(u32x2*)p = w; }

__device__ __forceinline__ void st8bf_swap(bf16_t* p_even, bf16_t* p_odd, u32x2 w0, u32x2 w1, int fq) {
    const auto rx = __builtin_amdgcn_permlane16_swap(w0.x, w1.x, false, false);
    const auto ry = __builtin_amdgcn_permlane16_swap(w0.y, w1.y, false, false);
    u32x4 o; o.x = rx[0]; o.y = ry[0]; o.z = rx[1]; o.w = ry[1];
    *(u32x4*)((fq & 1) ? p_odd : p_even) = o;
}
__device__ __forceinline__ u32x2 pk4(float a, float b, float c, float d) { u32x2 w; w.x = cvt_pk(a, b); w.y = cvt_pk(c, d); return w; }

struct EpiG1 {
    bf16_t *Q, *KV, *B1, *B2, *Z; float* newk; float* newv; int layer;
    __device__ __forceinline__ void operator()(const f32x4 (&acc)[2][2][4][2], const Unit& u, int wr, int wc, int fr, int fq) const {
        const int row0 = u.pm * 256 + wr * 64 + fr;
        const int kind = u.kind;
        if (kind == K_Q || kind == K_KV) {
            const bool lat = u.pm >= 16;
            float invf[4];
#pragma unroll
            for (int j = 0; j < 4; ++j) invf[j] = exp2f(-(float)(4 * fq + j) * 0.83048202372184f);
            const int seg = wc & 1;
#pragma unroll
            for (int ai = 0; ai < 2; ++ai)
#pragma unroll
                for (int m = 0; m < 4; ++m) {
                    const int r = row0 + ai * 128 + m * 16;
                    float cs[4], sn[4];
                    if (lat) { const int tok = (r - TP) & 4095; const float pos = (float)(seg ? (tok & 63) : (tok >> 6));
#pragma unroll
                        for (int j = 0; j < 4; ++j) { const float ang = pos * invf[j]; cs[j] = __cosf(ang); sn[j] = __sinf(ang); } }
                    else {
#pragma unroll
                        for (int j = 0; j < 4; ++j) { cs[j] = 1.f; sn[j] = 0.f; } }
                    if (kind == K_Q) {
#pragma unroll
                        for (int bj = 0; bj < 2; ++bj) { const f32x4 x1 = acc[ai][bj][m][0], x2 = acc[ai][bj][m][1]; float o1[4], o2[4];
#pragma unroll
                            for (int j = 0; j < 4; ++j) { o1[j] = (x1[j] * cs[j] - x2[j] * sn[j]) * 0.18033688011112042f; o2[j] = (x2[j] * cs[j] + x1[j] * sn[j]) * 0.18033688011112042f; }
                            bf16_t* p = Q + (size_t)r * 512 + u.pn * 256 + bj * 128 + wc * 32 + 4 * fq;
                            st8bf_swap(p, p + 12, pk4(o1[0], o1[1], o1[2], o1[3]), pk4(o2[0], o2[1], o2[2], o2[3]), fq); }
                    } else {
                        { const f32x4 x1 = acc[ai][0][m][0], x2 = acc[ai][0][m][1]; float o1[4], o2[4];
#pragma unroll
                            for (int j = 0; j < 4; ++j) { o1[j] = x1[j] * cs[j] - x2[j] * sn[j]; o2[j] = x2[j] * cs[j] + x1[j] * sn[j]; }
                            bf16_t* p = KV + (size_t)r * 256 + wc * 32 + 4 * fq;
                            st8bf_swap(p, p + 12, pk4(o1[0], o1[1], o1[2], o1[3]), pk4(o2[0], o2[1], o2[2], o2[3]), fq);
                            if (!lat) { float* o = newk + ((size_t)((r >> 8) * 2 + layer) * 256 + (r & 255)) * 128 + wc * 32 + 4 * fq; *(f32x4*)o = x1; *(f32x4*)(o + 16) = x2; } }
                        { const f32x4 v1 = acc[ai][1][m][0], v2 = acc[ai][1][m][1];
                            bf16_t* p = KV + (size_t)r * 256 + 128 + wc * 32 + 4 * fq;
                            st8bf_swap(p, p + 12, pk4(v1[0], v1[1], v1[2], v1[3]), pk4(v2[0], v2[1], v2[2], v2[3]), fq);
                            if (!lat) { float* o = newv + ((size_t)((r >> 8) * 2 + layer) * 256 + (r & 255)) * 128 + wc * 32 + 4 * fq; *(f32x4*)o = v1; *(f32x4*)(o + 16) = v2; } }
                    }
                }
        } else if (kind == K_CONV) {
            const int t = u.pn - 5; const bool wt = t < 4;
            const int ch = 128 * (t & 3) + 32 * wc + 4 * fq + (wt ? 0 : 512);
#pragma unroll
            for (int ai = 0; ai < 2; ++ai)
#pragma unroll
                for (int m = 0; m < 4; ++m) {
                    const int r = row0 + ai * 128 + m * 16;
                    u32x2 w[2];
#pragma unroll
                    for (int n = 0; n < 2; ++n) { const f32x4 a0 = acc[ai][0][m][n], a1 = acc[ai][1][m][n];
                        w[n] = wt ? pk4(a0[0] * silu_f(a1[0]), a0[1] * silu_f(a1[1]), a0[2] * silu_f(a1[2]), a0[3] * silu_f(a1[3])) : pk4(a0[0] * a1[0], a0[1] * a1[1], a0[2] * a1[2], a0[3] * a1[3]); }
                    bf16_t* p = B2 + (size_t)r * 1024 + ch;
                    st8bf_swap(p, p + 12, w[0], w[1], fq);
                }
        } else {
#ifdef TEST_NOZ
            if (kind == K_Z) return;
#endif
            bf16_t* base; int colt; const bool act = (kind != K_Z);
            if (kind == K_ZA) { base = B1; colt = (u.pn - 3) * 256; } else if (kind == K_Z) { base = Z; colt = (u.pn - 13) * 256; } else { base = B1; colt = 512 + (u.pn - 17) * 256; }
#pragma unroll
            for (int ai = 0; ai < 2; ++ai)
#pragma unroll
                for (int m = 0; m < 4; ++m) {
                    const int r = row0 + ai * 128 + m * 16;
#pragma unroll
                    for (int bj = 0; bj < 2; ++bj) { f32x4 v0 = acc[ai][bj][m][0], v1 = acc[ai][bj][m][1];
                            if (act) { v0[0] = silu_f(v0[0]); v0[1] = silu_f(v0[1]); v0[2] = silu_f(v0[2]); v0[3] = silu_f(v0[3]); v1[0] = silu_f(v1[0]); v1[1] = silu_f(v1[1]); v1[2] = silu_f(v1[2]); v1[3] = silu_f(v1[3]); }
                            bf16_t* pp = base + (size_t)r * 1024 + colt + bj * 128 + wc * 32 + 4 * fq;
                            st8bf_swap(pp, pp + 12, pk4(v0[0], v0[1], v0[2], v0[3]), pk4(v1[0], v1[1], v1[2], v1[3]), fq); }
                }
        }
    }
};

struct EpiGate {
    unsigned char* wsb; float* dbg_out;
    __device__ __forceinline__ void operator()(const f32x4 (&acc)[2][2][4][2], const Unit& u, int wr, int wc, int fr, int fq) const {
        const int b = u.pn >> 2, pn = u.pn & 3;
        int tid = threadIdx.x; asm volatile("" : "+v"(tid));
        const size_t goff = b == 0 ? WS_Z : (b == 1 ? WS_Q : WS_GT2);
        u32x2* blk = (u32x2*)(wsb + goff) + (size_t)(u.pm * 4 + pn) * 16384 + tid;
#pragma unroll
        for (int ai = 0; ai < 2; ++ai)
#pragma unroll
            for (int bj = 0; bj < 2; ++bj)
#pragma unroll
                for (int m = 0; m < 4; ++m)
#pragma unroll
                    for (int n = 0; n < 2; ++n) { const f32x4 v = acc[ai][bj][m][n]; u32x2 w; w.x = cvt_pk(sigm_f(v[0]), sigm_f(v[1])); w.y = cvt_pk(sigm_f(v[2]), sigm_f(v[3]));
                        blk[(((ai * 2 + bj) * 4 + m) * 2 + n) * 512] = w; }
    }
};
struct EpiP {
    unsigned char* wsb; bf16_t* MG;
    __device__ __forceinline__ void operator()(const f32x4 (&acc)[2][2][4][2], const Unit& u, int wr, int wc, int fr, int fq) const {
        const int pn = u.pn & 3, b = u.pn >> 4;
        int tid = threadIdx.x; asm volatile("" : "+v"(tid));
        const size_t tb = (size_t)(u.pm * 4 + pn) * 8192 + tid;
        const u32x4* gblk = (const u32x4*)(wsb + (b == 0 ? WS_Z : (b == 1 ? WS_Q : WS_GT2))) + tb;
        u32x4* sblk = (u32x4*)(wsb + WS_Z) + tb;
        const size_t off0 = (size_t)(u.pm * 256 + wr * 64 + fr) * 1024 + pn * 256 + wc * 32 + 4 * fq;
        constexpr int DEPTH = 3;
        u32x4 gq[8][2], oq[8][2];
#define EPIP_LOAD(gi) do { _Pragma("unroll") for (int bj = 0; bj < 2; ++bj) { const int ps = (((gi) >> 2) * 2 + bj) * 4 + ((gi) & 3); \
            gq[gi][bj] = gblk[ps * 512]; oq[gi][bj] = (u32x4){0u, 0u, 0u, 0u}; if (b > 0) oq[gi][bj] = sblk[ps * 512]; } } while (0)
#pragma unroll
        for (int gi = 0; gi < DEPTH; ++gi) EPIP_LOAD(gi);
#pragma unroll
        for (int gi = 0; gi < 8; ++gi) {
            const int ai = gi >> 2, m = gi & 3;
            if (gi + DEPTH < 8) EPIP_LOAD(gi + DEPTH);
#pragma unroll
            for (int bj = 0; bj < 2; ++bj) {
                const f32x4 v0 = acc[ai][bj][m][0], v1 = acc[ai][bj][m][1]; const u32x4 g = gq[gi][bj], o = oq[gi][bj];
                const float a0 = bflo(g.x) * v0[0] + bflo(o.x), a1 = bfhi(g.x) * v0[1] + bfhi(o.x), a2 = bflo(g.y) * v0[2] + bflo(o.y), a3 = bfhi(g.y) * v0[3] + bfhi(o.y);
                const float c0 = bflo(g.z) * v1[0] + bflo(o.z), c1 = bfhi(g.z) * v1[1] + bfhi(o.z), c2 = bflo(g.w) * v1[2] + bflo(o.w), c3 = bfhi(g.w) * v1[3] + bfhi(o.w);
                if (b == 2) { bf16_t* p = MG + off0 + (size_t)(ai * 128 + m * 16) * 1024 + bj * 128;
                    __hip_atomic_store((unsigned long long*)p, (unsigned long long)cvt_pk(a0, a1) | ((unsigned long long)cvt_pk(a2, a3) << 32), __ATOMIC_RELAXED, __HIP_MEMORY_SCOPE_AGENT);
                    __hip_atomic_store((unsigned long long*)(p + 16), (unsigned long long)cvt_pk(c0, c1) | ((unsigned long long)cvt_pk(c2, c3) << 32), __ATOMIC_RELAXED, __HIP_MEMORY_SCOPE_AGENT); }
                else { u32x4 w; w.x = cvt_pk(a0, a1); w.y = cvt_pk(a2, a3); w.z = cvt_pk(c0, c1); w.w = cvt_pk(c2, c3); sblk[((ai * 2 + bj) * 4 + m) * 512] = w; }
            }
        }
#undef EPIP_LOAD
    }
};

struct EpiOut {
    const float *xp, *xs; float* Y; const float* mod; int layer;
    __device__ __forceinline__ void operator()(const f32x4 (&acc)[2][2][4][2], const Unit& u, int wr, int wc, int fr, int fq) const {
        const float* xin = layer == 0 ? (u.pm < 16 ? xp : xs - (size_t)TP * DM) : Y;
        const int cond = u.pm < 16 ? 0 : 1 + ((u.pm - 16) >> 4);
        const float* gp = mod + (size_t)(layer * 9 + cond) * 3072 + 2048 + u.pn * 256 + wc * 32 + 4 * fq;
        const size_t off0 = (size_t)(u.pm * 256 + wr * 64 + fr) * DM + u.pn * 256 + wc * 32 + 4 * fq;
        constexpr int DEPTH = 3;
        f32x4 gv[4], xq[8][4];
#define EPIO_LOAD(gi) do { _Pragma("unroll") for (int q = 0; q < 4; ++q) xq[gi][q] = __builtin_nontemporal_load((const f32x4*)(xin + off0 + (size_t)((((gi) >> 2) * 128) + ((gi) & 3) * 16) * DM + (q >> 1) * 128 + (q & 1) * 16)); } while (0)
#pragma unroll
        for (int q = 0; q < 4; ++q) gv[q] = *(const f32x4*)(gp + (q >> 1) * 128 + (q & 1) * 16);
#pragma unroll
        for (int gi = 0; gi < DEPTH; ++gi) EPIO_LOAD(gi);
#pragma unroll
        for (int gi = 0; gi < 8; ++gi) {
            const int ai = gi >> 2, m = gi & 3;
            if (gi + DEPTH < 8) EPIO_LOAD(gi + DEPTH);
#pragma unroll
            for (int q = 0; q < 4; ++q) *(f32x4*)(Y + off0 + (size_t)(ai * 128 + m * 16) * DM + (q >> 1) * 128 + (q & 1) * 16) = xq[gi][q] * 1.41421356237f + gv[q] * acc[ai][q >> 1][m][q & 1];
        }
#undef EPIO_LOAD
    }
};


struct SchedPG {
    const char *B1, *B2, *Wac, *Wb, *MGp, *W3; unsigned* cnt; int G, c; const char *Hp, *Wg;
    __device__ __forceinline__ bool next(int i0, Unit& u) const {
        const int cr = G - 1 - c;
        if (i0 < 7) { SchedGate sg{Hp, Wg, G, cr}; if (sg.next(i0, u)) { if (i0 == (cr < 192 ? 6 : 5)) u.pn |= 0x100; return true; } }
        const int i = i0 - (cr < 192 ? 7 : 6);
        const int x = c & 7, s = c >> 3, nch = s < 8 ? 3 : 2;
        if (i < 3 * nch) {
            const int j = i / 3, b = i - 3 * j; int pm, pn; (void)tile_of(j, G, c, pm, pn);
            u.pm = pm; u.pn = pn | (b << 4); u.kind = K_P; u.nt = 8;
            u.a = (b == 1 ? B2 : B1) + (size_t)pm * pg8::TSTEP + (b == 2 ? 1024 : 0);
            u.b = (b == 1 ? Wb : Wac) + (size_t)pn * pg8::TSTEP + (b == 2 ? 1024 : 0);
            return true;
        }
        const int k = i - 3 * nch, nG = s < 8 ? 1 : (s < 24 ? 3 : 2);
        if (k >= nG) return false;
        int pm, pn;
        if (k == 0) { pm = x * 8 + (s >> 2); pn = s & 3; }
        else { const int uu = (k == 1) ? (s - 8) : (24 + s - 8);
            if (uu < 32) { pm = 64 + x * 8 + (uu >> 2); pn = uu & 3; } else { pm = 128 + 2 * x + ((uu - 32) >> 2); pn = (uu - 32) & 3; } }
        u.pm = pm; u.pn = pn; u.kind = K_OUT; u.nt = 16; u.a = MGp + (size_t)pm * pg8::TSTEP; u.b = W3 + (size_t)pn * pg8::TSTEP; return true;
    }
    __device__ __forceinline__ void a_ready(const Unit& n) const {
        if (n.kind != K_OUT) return;
        unsigned* p = cnt + n.pm; unsigned sp = 0;
        while (__hip_atomic_load(p, __ATOMIC_RELAXED, __HIP_MEMORY_SCOPE_AGENT) < 32u) { __builtin_amdgcn_s_sleep(2); if (++sp > (1u << 21)) break; }
        asm volatile("s_waitcnt vmcnt(0)" ::: "memory");
    }
};
struct EpiPG {
    EpiP ep; EpiOut eo; unsigned* cnt; unsigned* cnt2; unsigned char* wsb; unsigned* cnt3; int Gw, cw;
    __device__ __forceinline__ void operator()(const f32x4 (&acc)[2][2][4][2], const Unit& u, int wr, int wc, int fr, int fq) const {
        if (u.kind == K_GATE) {
            const int pn12 = u.pn & 0xff, b = pn12 >> 2, pn = pn12 & 3;
            int tid = threadIdx.x; asm volatile("" : "+v"(tid));
            const size_t goff = b == 0 ? WS_Z : (b == 1 ? WS_Q : WS_GT2);
            u32x4* blk = (u32x4*)(wsb + goff) + (size_t)(u.pm * 4 + pn) * 8192 + tid;
#pragma unroll
            for (int ai = 0; ai < 2; ++ai)
#pragma unroll
                for (int bj = 0; bj < 2; ++bj)
#pragma unroll
                    for (int m = 0; m < 4; ++m) { const f32x4 v0 = acc[ai][bj][m][0], v1 = acc[ai][bj][m][1]; u32x4 w;
                        w.x = cvt_pk(sigm_f(v0[0]), sigm_f(v0[1])); w.y = cvt_pk(sigm_f(v0[2]), sigm_f(v0[3])); w.z = cvt_pk(sigm_f(v1[0]), sigm_f(v1[1])); w.w = cvt_pk(sigm_f(v1[2]), sigm_f(v1[3]));
                        blk[((ai * 2 + bj) * 4 + m) * 512] = w; }
            if (u.pn & 0x100) {
                asm volatile("s_waitcnt vmcnt(0)" ::: "memory");
                __builtin_amdgcn_s_barrier();
                if (threadIdx.x < 64) {
                    __builtin_amdgcn_fence(__ATOMIC_RELEASE, "agent");
                    asm volatile("s_waitcnt vmcnt(0)" ::: "memory");
                    if (threadIdx.x == 0) { const int cr = Gw - 1 - cw; SchedGate sg{nullptr, nullptr, Gw, cr}; Unit t;
                        for (int i = 0; i < 7; ++i) { if (!sg.next(i, t)) break;
                            (void)__hip_atomic_fetch_add(cnt2 + (t.pm * 4 + (t.pn & 3)) * 3 + (t.pn >> 2), 8u, __ATOMIC_RELAXED, __HIP_MEMORY_SCOPE_AGENT);
                            (void)__hip_atomic_fetch_add(cnt3 + t.pm, 8u, __ATOMIC_RELAXED, __HIP_MEMORY_SCOPE_AGENT); } }
                }
            }
        } else if (u.kind == K_P) {
            { unsigned* p = cnt2 + (u.pm * 4 + (u.pn & 3)) * 3 + (u.pn >> 4); unsigned sp = 0;
              while (__hip_atomic_load(p, __ATOMIC_RELAXED, __HIP_MEMORY_SCOPE_AGENT) < 8u) { __builtin_amdgcn_s_sleep(2); if (++sp > (1u << 21)) break; }
              if ((u.pn >> 4) == 2) { unsigned* p3 = cnt3 + u.pm; sp = 0;
                  while (__hip_atomic_load(p3, __ATOMIC_RELAXED, __HIP_MEMORY_SCOPE_AGENT) < 96u) { __builtin_amdgcn_s_sleep(2); if (++sp > (1u << 21)) break; } }
              asm volatile("s_waitcnt vmcnt(0)" ::: "memory"); }
            ep(acc, u, wr, wc, fr, fq);
            if ((u.pn >> 4) == 2) {
                asm volatile("s_waitcnt vmcnt(0)" ::: "memory");
                if ((threadIdx.x & 63) == 0) (void)__hip_atomic_fetch_add(cnt + u.pm, 1u, __ATOMIC_RELAXED, __HIP_MEMORY_SCOPE_AGENT);
            }
        } else eo(acc, u, wr, wc, fr, fq);
    }
};

__device__ __forceinline__ int srcmap1(int n) {
    if (n < 1280) return n;
    if (n < 3328) { const int t = (n - 1280) >> 8, cl = (n - 1280) & 255, bj = cl >> 7, ch = 128 * (t & 3) + (cl & 127);
        return (t < 4 ? (bj ? 2816 : 1280) : (bj ? 2304 : 1792)) + ch; }
    return 3840 + (n - 4352);
}
__device__ __forceinline__ void transpose_item(const float* W, int N, int srccol, int k0, bf16_t* WT, int n0, int coff, LAS float* scr, int lane) {
#pragma unroll 8
    for (int i = 0; i < 32; ++i) { const int kk = 2 * i + (lane >> 5); scr[kk * 33 + (lane & 31)] = W[(size_t)(k0 + kk) * N + srccol]; }
    asm volatile("s_waitcnt lgkmcnt(0)" ::: "memory");
    const int c = lane & 7;
#pragma unroll
    for (int j = 0; j < 4; ++j) { const int n = (lane >> 3) + 8 * j; const LAS float* s = scr + (8 * c) * 33 + n;
        u32x4 o; o.x = pk2(s[0 * 33], s[1 * 33]); o.y = pk2(s[2 * 33], s[3 * 33]); o.z = pk2(s[4 * 33], s[5 * 33]); o.w = pk2(s[6 * 33], s[7 * 33]);
        *(u32x4*)(WT + (size_t)(n0 + n) * 1024 + coff + k0 + 8 * c) = o; }
    asm volatile("s_waitcnt lgkmcnt(0)" ::: "memory");
}

__device__ __forceinline__ void phase0(const Args& a, LAS unsigned char* lds, int G, int c) {
    int tid = threadIdx.x; asm volatile("" : "+v"(tid));
    const int lane = tid & 63, wave = tid >> 6;
    size_t z0 = 0; asm volatile("" : "+s"(z0)); unsigned char* ws = a.ws + z0;
#ifdef TEST_ZEROWS
    { u32x4* zp = (u32x4*)(ws + WS_SCR); const size_t nz = (WS_END - WS_SCR) / 16; const u32x4 zz = {0u, 0u, 0u, 0u};
      for (size_t e = (size_t)c * 512 + tid; e < nz; e += (size_t)G * 512) zp[e] = zz; }
#endif
    { bf16_t* FM = (bf16_t*)(ws + WS_FMAT);
      for (int e = c * 512 + tid; e < 32768; e += G * 512) {
          float val;
          if (e < 16384) { const int rho = e >> 7, k = e & 127, k1 = rho & 63, s1 = k & 63; const float fr = (float)((k1 * s1) & 63) * (1.f / 64.f);
              const float cs = __builtin_amdgcn_cosf(fr), sn = __builtin_amdgcn_sinf(fr); val = rho < 64 ? (k < 64 ? cs : sn) : (k < 64 ? -sn : cs); }
          else if (e < 24576) { const int e2 = e - 16384, k2 = e2 >> 7, k = e2 & 127, s2 = k & 63; const float fr = (float)((k2 * s2) & 63) * (1.f / 64.f);
              val = k < 64 ? __builtin_amdgcn_cosf(fr) : __builtin_amdgcn_sinf(fr); }
          else { const int e2 = e - 24576, rho = e2 >> 7, k = e2 & 127, r = k & 63, k1l = rho >> 2, k2 = rho & 3, k1r = r >> 2, s2 = r & 3; const float fr = (float)((k2 * s2) & 3) * 0.25f;
              val = (k1l == k1r) ? (k < 64 ? __builtin_amdgcn_cosf(fr) : __builtin_amdgcn_sinf(fr)) : 0.f; }
          FM[e] = (bf16_t)f2bf(val);
      } }
    { u32x4* ck = (u32x4*)(ws + WS_CK); u32x4* cv = (u32x4*)(ws + WS_CV);
      for (int e = c * 512 + tid; e < 2 * 131072; e += G * 512) {
          const int which = e >= 131072, i = e & 131071; const float* src = (which ? a.cache_v : a.cache_k) + (size_t)i * 8;
          const f32x4 v0 = *(const f32x4*)src, v1 = *(const f32x4*)(src + 4);
          u32x4 o; o.x = pk2(v0[0], v0[1]); o.y = pk2(v0[2], v0[3]); o.z = pk2(v1[0], v1[1]); o.w = pk2(v1[2], v1[3]);
          (which ? cv : ck)[i] = o; } }
    if (c < 96) {
        LAS float* sl = (LAS float*)lds; LAS float* red = (LAS float*)(lds + 36864);
        for (int e = tid; e < 9216; e += 512) { const int j = e >> 10, k = e & 1023; const float v = (j == 0) ? a.c_ctx[k] : a.c[(j - 1) * 1024 + k]; sl[e] = v / (1.0f + expf(-v)); }
        __syncthreads();
        const int l = c / 48, cb = c % 48, col = cb * 64 + (tid & 63), kq = tid >> 6;
        float acc[9];
#pragma unroll
        for (int j = 0; j < 9; ++j) acc[j] = 0.f;
        const float* wp = a.w_mod + ((size_t)l * 1024 + kq * 128) * 3072 + col;
        for (int k = 0; k < 128; k += 16) { float w[16];
#pragma unroll
            for (int u = 0; u < 16; ++u) w[u] = wp[(size_t)(k + u) * 3072];
#pragma unroll
            for (int u = 0; u < 16; ++u)
#pragma unroll
                for (int j = 0; j < 9; ++j) acc[j] += sl[j * 1024 + kq * 128 + k + u] * w[u]; }
#pragma unroll
        for (int j = 0; j < 9; ++j) red[(kq * 9 + j) * 64 + (tid & 63)] = acc[j];
        __syncthreads();
        float* MOD = (float*)(ws + WS_MOD);
        for (int e = tid; e < 576; e += 512) { const int j = e >> 6, cl = e & 63; float s = 0.f;
#pragma unroll
            for (int q = 0; q < 8; ++q) s += red[(q * 9 + j) * 64 + cl];
            MOD[(size_t)(l * 9 + j) * 3072 + cb * 64 + cl] = s + a.b_mod[l * 3072 + cb * 64 + cl]; }
    }
    for (int item = c; item < 256; item += G) {
        const int l = item >> 7, g = (item >> 5) & 3, kb = item & 31, k0 = kb * 32;
        LAS float* Wt = (LAS float*)lds; LAS float* tabc = (LAS float*)(lds + 16384); LAS float* tabs = (LAS float*)(lds + 16384 + 512);
        __syncthreads();
        for (int e = tid; e < 4096; e += 512) { const int kk = e >> 7, cc = e & 127; Wt[e] = a.w_in[((size_t)l * 1024 + k0 + kk) * INW + 3328 + g * 128 + cc]; }
        if (tid < 128) { const float fr = (float)tid * (1.f / 128.f); tabc[tid] = __builtin_amdgcn_cosf(fr); tabs[tid] = __builtin_amdgcn_sinf(fr); }
        __syncthreads();
        const int nl = tid & 255, part = nl >> 7, m = nl & 127, kh = tid >> 8;
        float o[16];
#pragma unroll
        for (int kk = 0; kk < 16; ++kk) o[kk] = 0.f;
        for (int cc = 0; cc < 128; ++cc) { const int ix = (m * cc) & 127; const float tv = part ? -tabs[ix] : tabc[ix];
#pragma unroll
            for (int kk = 0; kk < 16; ++kk) o[kk] += Wt[(16 * kh + kk) * 128 + cc] * tv; }
        bf16_t* dst = (bf16_t*)(ws + WS_BT1 + (size_t)l * BT1_L) + (size_t)(3328 + part * 512 + g * 128 + m) * 1024 + k0 + 16 * kh;
        u32x4 w0, w1; w0.x = pk2(o[0], o[1]); w0.y = pk2(o[2], o[3]); w0.z = pk2(o[4], o[5]); w0.w = pk2(o[6], o[7]);
        w1.x = pk2(o[8], o[9]); w1.y = pk2(o[10], o[11]); w1.z = pk2(o[12], o[13]); w1.w = pk2(o[14], o[15]);
        *(u32x4*)dst = w0; *(u32x4*)(dst + 8) = w1;
    }
    __syncthreads();
    { LAS float* scr = (LAS float*)(lds + wave * 16384);
      const int gw = c * 8 + wave, NGW = G * 8;
      for (int it = gw; it < 2 * 4736; it += NGW) {
          const int l = it / 4736; int r = it - l * 4736;
          if (r < 1920) { const int nb = r >> 4, kb = r & 15, n0 = nb < 104 ? nb * 32 : 4352 + (nb - 104) * 32;
              transpose_item(a.w_in + (size_t)l * 1024 * INW, INW, srcmap1(n0 + (lane & 31)), kb * 64, (bf16_t*)(ws + WS_BT1 + (size_t)l * BT1_L), n0, 0, scr, lane); continue; }
          r -= 1920;
          if (r < 1536) { const int nb = r >> 4, kb = r & 15, n0 = nb * 32;
              transpose_item(a.w_in + (size_t)l * 1024 * INW, INW, 4352 + n0 + (lane & 31), kb * 64, (bf16_t*)(ws + WS_BT1G + (size_t)l * BT1G_L), n0, 0, scr, lane); continue; }
          r -= 1536;
          if (r < 768) { const int b = r >> 8, rr = r & 255, nb = rr >> 3, kb = rr & 7, n0 = nb * 32;
              bf16_t* dst = (bf16_t*)(ws + (b == 1 ? WS_BT2B : WS_BT2AC) + (size_t)l * BT2_L);
              transpose_item(a.w_branch + (size_t)(l * 3 + b) * 512 * 1024, 1024, n0 + (lane & 31), kb * 64, dst, n0, b == 2 ? 512 : 0, scr, lane); continue; }
          r -= 768;
          { const int nb = r >> 4, kb = r & 15, n0 = nb * 32;
              transpose_item(a.w_o + (size_t)l * 1024 * 1024, 1024, n0 + (lane & 31), kb * 64, (bf16_t*)(ws + WS_BT3 + (size_t)l * BT2_L), n0, 0, scr, lane); }
      } }
}

__device__ __forceinline__ void ln_phase(const Args& a, int mode, int layer, int G, int c) {
    int tid = threadIdx.x; asm volatile("" : "+v"(tid));
    const int lane = tid & 63, wave = tid >> 6;
    const float* MOD = (const float*)(a.ws + WS_MOD);
    bf16_t* H = (bf16_t*)(a.ws + WS_H);
    f32x4 nv[4];
    { const int m = c * 8 + wave;
      if (m < TT) { const float* src = mode == 0 ? (m < TP ? a.x_prompt + (size_t)m * DM : a.x_sample + (size_t)(m - TP) * DM) : a.out + (size_t)m * DM;
#pragma unroll
          for (int j = 0; j < 4; ++j) nv[j] = __builtin_nontemporal_load((const f32x4*)(src + 4 * lane + 256 * j)); } }
    for (int m = c * 8 + wave; m < TT; m += G * 8) {
        f32x4 v[4]; float s = 0.f;
#pragma unroll
        for (int j = 0; j < 4; ++j) { v[j] = nv[j]; s += (v[j][0] + v[j][1]) + (v[j][2] + v[j][3]); }
        { const int m2 = m + G * 8;
          if (m2 < TT) { const float* src2 = mode == 0 ? (m2 < TP ? a.x_prompt + (size_t)m2 * DM : a.x_sample + (size_t)(m2 - TP) * DM) : a.out + (size_t)m2 * DM;
#pragma unroll
              for (int j = 0; j < 4; ++j) nv[j] = __builtin_nontemporal_load((const f32x4*)(src2 + 4 * lane + 256 * j)); } }
        float mean = wave_sum(s) * (1.f / DM), s2 = 0.f;
#pragma unroll
        for (int j = 0; j < 4; ++j) { v[j] = v[j] - mean; s2 += (v[j][0] * v[j][0] + v[j][1] * v[j][1]) + (v[j][2] * v[j][2] + v[j][3] * v[j][3]); }
        float rstd = 1.0f / sqrtf(wave_sum(s2) * (1.f / DM) + 1e-6f);
        bool make_h = true; int hl = 0;
        if (mode == 1) {
            float* dst = a.out + (size_t)m * DM; s = 0.f;
#pragma unroll
            for (int j = 0; j < 4; ++j) { const f32x4 g = *(const f32x4*)(a.ln_g + layer * DM + 4 * lane + 256 * j), b = *(const f32x4*)(a.ln_b + layer * DM + 4 * lane + 256 * j);
                v[j] = v[j] * rstd * g + b; if (layer == 1) __builtin_nontemporal_store(v[j], (f32x4*)(dst + 4 * lane + 256 * j)); else *(f32x4*)(dst + 4 * lane + 256 * j) = v[j]; s += (v[j][0] + v[j][1]) + (v[j][2] + v[j][3]); }
            make_h = (layer == 0); hl = 1;
            if (make_h) { mean = wave_sum(s) * (1.f / DM); s2 = 0.f;
#pragma unroll
                for (int j = 0; j < 4; ++j) { v[j] = v[j] - mean; s2 += (v[j][0] * v[j][0] + v[j][1] * v[j][1]) + (v[j][2] * v[j][2] + v[j][3] * v[j][3]); }
                rstd = 1.0f / sqrtf(wave_sum(s2) * (1.f / DM) + 1e-6f); }
        }
        if (make_h) {
            const float* mp = MOD + (size_t)(hl * 9 + cond_of_row(m)) * 3072;
#pragma unroll
            for (int j = 0; j < 4; ++j) { const f32x4 sh = *(const f32x4*)(mp + 4 * lane + 256 * j), sc = *(const f32x4*)(mp + 1024 + 4 * lane + 256 * j);
                const f32x4 h = v[j] * rstd * (sc + 1.0f) + sh; u32x2 w; w.x = pk2(h[0], h[1]); w.y = pk2(h[2], h[3]);
                *(u32x2*)(H + (size_t)m * DM + 4 * lane + 256 * j) = w; }
        }
    }
}

__device__ __forceinline__ void conv_phase(const Args& a, int layer, int G, int c) {
    bf16_t* B2 = (bf16_t*)(a.ws + WS_BUF2);
    const float* cw = a.conv_w + (size_t)layer * 3 * 512;
    int tid = threadIdx.x; asm volatile("" : "+v"(tid));
    const int stride = G * 512;
    for (int e0 = c * 512 + tid; e0 < TT * 64; e0 += 2 * stride) {
        u32x4 u0[2], u1[2], u2[2], w[2]; int mm[2], cc[2]; bool ok[2];
#pragma unroll
        for (int k = 0; k < 2; ++k) {
            const int e = e0 + k * stride; ok[k] = e < TT * 64; const int ee = ok[k] ? e : e0;
            const int m = ee >> 6, ch = (ee & 63) * 8; mm[k] = m; cc[k] = ch;
            const int s = m < TP ? (m & 255) : ((m - TP) & 4095), S = m < TP ? 256 : 4096;
            const u32x4 zero = {0u, 0u, 0u, 0u};
            u1[k] = *(const u32x4*)(B2 + (size_t)m * 1024 + 512 + ch);
            u0[k] = s > 0 ? *(const u32x4*)(B2 + (size_t)(m - 1) * 1024 + 512 + ch) : zero;
            u2[k] = s < S - 1 ? *(const u32x4*)(B2 + (size_t)(m + 1) * 1024 + 512 + ch) : zero;
            w[k] = __builtin_nontemporal_load((const u32x4*)(B2 + (size_t)m * 1024 + ch));
        }
#pragma unroll
        for (int k = 0; k < 2; ++k) {
            const int ch = cc[k];
            float y[8];
#pragma unroll
            for (int i = 0; i < 4; ++i) {
                const float c0a = cw[ch + 2 * i], c0b = cw[ch + 2 * i + 1], c1a = cw[512 + ch + 2 * i], c1b = cw[512 + ch + 2 * i + 1], c2a = cw[1024 + ch + 2 * i], c2b = cw[1024 + ch + 2 * i + 1];
                y[2 * i] = bflo(w[k][i]) * (c0a * bflo(u0[k][i]) + c1a * bflo(u1[k][i]) + c2a * bflo(u2[k][i]));
                y[2 * i + 1] = bfhi(w[k][i]) * (c0b * bfhi(u0[k][i]) + c1b * bfhi(u1[k][i]) + c2b * bfhi(u2[k][i]));
            }
            u32x4 o; o.x = pk2(y[0], y[1]); o.y = pk2(y[2], y[3]); o.z = pk2(y[4], y[5]); o.w = pk2(y[6], y[7]);
            if (ok[k]) *(u32x4*)(B2 + (size_t)mm[k] * 1024 + ch) = o;
        }
    }
}

constexpr int FP = 136;
constexpr int FTP = 264;
typedef short v4i16_t __attribute__((ext_vector_type(4)));
__device__ __forceinline__ void fft_phase(const Args& a, LAS unsigned char* lds, int stage, int G, int c, unsigned* cntf) {
    int tid = threadIdx.x; asm volatile("" : "+v"(tid));
    const int wave = __builtin_amdgcn_readfirstlane(tid >> 6), lane = tid & 63, cq = lane & 15, qq = lane >> 4;
    bf16_t* Z = (bf16_t*)(a.ws + WS_Z); bf16_t* B1 = (bf16_t*)(a.ws + WS_BUF1);
    const bf16_t* FM = (const bf16_t*)(a.ws + WS_FMAT);
    LAS bf16_t* F0 = (LAS bf16_t*)lds;
    LAS bf16_t* DT = (LAS bf16_t*)(lds + 128 * FP * 2);
    __syncthreads();
    { const bf16_t* src = FM + (stage == 0 ? 0 : 16384);
      for (int e = tid; e < 2048; e += 512) { const int row = e >> 4, ch = e & 15; *(LAS u32x4*)(F0 + row * FP + ch * 8) = *(const u32x4*)(src + row * 128 + ch * 8); } }
    u32x4 rg[8];
#define FFT_DECODE(LL, lat_, base_, os_, cs_, jb_, oabs0_) do { lat_ = (LL) < 1024; oabs0_ = 0; \
        if (lat_) { const int b_ = (LL) >> 7, blk_ = ((LL) >> 3) & 15; jb_ = (LL) & 7; \
            if (stage == 0) { base_ = TP + b_ * 4096 + 4 * blk_; os_ = 1; cs_ = 64; oabs0_ = 4 * blk_; } else { base_ = TP + b_ * 4096 + 256 * blk_; os_ = 64; cs_ = 1; oabs0_ = 4 * blk_; } } \
        else { const int Lc_ = (LL) - 1024, b_ = Lc_ >> 3; jb_ = Lc_ & 7; \
            if (stage == 0) { base_ = b_ * 256; os_ = 1; cs_ = 4; } else { base_ = b_ * 256; os_ = 64; cs_ = 1; } } } while (0)
#define FFT_LOAD(base_, os_, cs_, jb_) do { const int c8_ = tid & 7, r_ = tid >> 3; \
        _Pragma("unroll") for (int i = 0; i < 8; ++i) { const int part = i & 1, o = i >> 1; \
            rg[i] = *(const u32x4*)(Z + (size_t)((base_) + o * (os_) + r_ * (cs_)) * 1024 + part * 512 + (jb_) * 64 + 8 * c8_); } } while (0)
#define FFT_WAIT(LL) do { if (stage == 1) { const int i_ = (LL) < 1024 ? (((LL) >> 7) * 8 + ((LL) & 7)) : 64 + ((LL) - 1024); const unsigned tg_ = (LL) < 1024 ? 16u : 1u; unsigned sp_ = 0; \
        while (__hip_atomic_load(cntf + i_, __ATOMIC_RELAXED, __HIP_MEMORY_SCOPE_AGENT) < tg_) { __builtin_amdgcn_s_sleep(2); if (++sp_ > (1u << 21)) break; } \
        asm volatile("s_waitcnt vmcnt(0)" ::: "memory"); } } while (0)
    { bool lat0; int b0, o0, c0, j0, a0; if (c < 1152) { FFT_WAIT(c); FFT_DECODE(c, lat0, b0, o0, c0, j0, a0); FFT_LOAD(b0, o0, c0, j0); } }
    for (int it = 0;; ++it) {
        const int L = it * G + c; if (L >= 1152) break;
        bool lat; int base, os, cs, jb, oabs0;
        FFT_DECODE(L, lat, base, os, cs, jb, oabs0);
        __syncthreads();
        { const int c8 = tid & 7, r = tid >> 3;
#pragma unroll
          for (int i = 0; i < 8; ++i) { const int part = i & 1, o = i >> 1;
              *(LAS u32x4*)(DT + (part * 64 + r) * FTP + o * 64 + 8 * c8) = rg[i]; } }
        __syncthreads();
        { const int L2 = L + G; if (L2 < 1152) { bool lat2; int b2_, o2_, c2_, j2_, a2_; FFT_WAIT(L2); FFT_DECODE(L2, lat2, b2_, o2_, c2_, j2_, a2_); FFT_LOAD(b2_, o2_, c2_, j2_); } }
        bf16x8 bfr[2][4];
#pragma unroll
        for (int nt = 0; nt < 2; ++nt) { const int col = 32 * wave + 16 * nt + cq;
#pragma unroll
            for (int ks = 0; ks < 4; ++ks) {
                const LAS bf16_t* p0 = DT + (32 * ks + 8 * qq + (cq >> 2)) * FTP + (col - cq) + 4 * (cq & 3);
                const v4i16_t t0 = __builtin_amdgcn_ds_read_tr16_b64_v4i16((LAS v4i16_t*)p0), t1 = __builtin_amdgcn_ds_read_tr16_b64_v4i16((LAS v4i16_t*)(p0 + 4 * FTP));
                bfr[nt][ks] = (bf16x8){t0[0], t0[1], t0[2], t0[3], t1[0], t1[1], t1[2], t1[3]}; } }
        const int o = wave >> 1;
        const int jj0 = 32 * (wave & 1) + cq;
        if (stage == 0) {
            f32x4 acc[8][2];
#pragma unroll
            for (int mt = 0; mt < 8; ++mt) { acc[mt][0] = (f32x4){0.f, 0.f, 0.f, 0.f}; acc[mt][1] = (f32x4){0.f, 0.f, 0.f, 0.f};
#pragma unroll
                for (int ks = 0; ks < 4; ++ks) { const bf16x8 af = *(const LAS bf16x8*)(F0 + (16 * mt + cq) * FP + 32 * ks + 8 * qq);
                    acc[mt][0] = __builtin_amdgcn_mfma_f32_16x16x32_bf16(af, bfr[0][ks], acc[mt][0], 0, 0, 0);
                    acc[mt][1] = __builtin_amdgcn_mfma_f32_16x16x32_bf16(af, bfr[1][ks], acc[mt][1], 0, 0, 0); } }
            const int s2abs = lat ? (oabs0 + o) : o; const int ntw_mask = lat ? 4095 : 255; const float ntw_inv = lat ? (1.f / 4096.f) : (1.f / 256.f);
            __syncthreads();
#pragma unroll
            for (int mt = 0; mt < 4; ++mt)
#pragma unroll
                for (int i = 0; i < 4; ++i) { const int k1 = 16 * mt + 4 * qq + i; const float fr = (float)((k1 * s2abs) & ntw_mask) * ntw_inv;
                    const float cs_ = __builtin_amdgcn_cosf(fr), sn_ = __builtin_amdgcn_sinf(fr);
                    LAS bf16_t* orow = DT + (o * 64 + k1) * FP + jj0;
#pragma unroll
                    for (int nt = 0; nt < 2; ++nt) { const float xr = acc[mt][nt][i], xi = acc[mt + 4][nt][i];
                        orow[16 * nt] = (bf16_t)f2bf(xr * cs_ + xi * sn_); orow[64 + 16 * nt] = (bf16_t)f2bf(xi * cs_ - xr * sn_); } }
            __syncthreads();
#pragma unroll
            for (int i = 0; i < 8; ++i) { const int id = tid + 512 * i, row = id >> 4, part = (id >> 3) & 1, ch = id & 7;
                const u32x4 v = *(const LAS u32x4*)(DT + row * FP + part * 64 + ch * 8);
                *(u32x4*)(Z + (size_t)(base + (row >> 6) * os + (row & 63) * cs) * 1024 + part * 512 + jb * 64 + ch * 8) = v; }
        } else {
            const LAS bf16_t* FB = lat ? F0 : F0 + 64 * FP;
            f32x4 acc[4][2];
#pragma unroll
            for (int mt = 0; mt < 4; ++mt) { acc[mt][0] = (f32x4){0.f, 0.f, 0.f, 0.f}; acc[mt][1] = (f32x4){0.f, 0.f, 0.f, 0.f};
#pragma unroll
                for (int ks = 0; ks < 4; ++ks) { const bf16x8 af = *(const LAS bf16x8*)(FB + (16 * mt + cq) * FP + 32 * ks + 8 * qq);
                    acc[mt][0] = __builtin_amdgcn_mfma_f32_16x16x32_bf16(af, bfr[0][ks], acc[mt][0], 0, 0, 0);
                    acc[mt][1] = __builtin_amdgcn_mfma_f32_16x16x32_bf16(af, bfr[1][ks], acc[mt][1], 0, 0, 0); } }
            const float nrm = lat ? 0.00138106793f   : 0.00552427173f  ;
            __syncthreads();
            LAS float* OT = (LAS float*)DT;
#pragma unroll
            for (int mt = 0; mt < 4; ++mt)
#pragma unroll
                for (int i = 0; i < 4; ++i) { const int rho = 16 * mt + 4 * qq + i;
#pragma unroll
                    for (int nt = 0; nt < 2; ++nt) OT[(o * 64 + rho) * 68 + jj0 + 16 * nt] = acc[mt][nt][i] * nrm; }
            __syncthreads();
#pragma unroll
            for (int i = 0; i < 4; ++i) { const int id = tid + 512 * i, row = id >> 3, ch = id & 7, oo = row >> 6, rho = row & 63;
                const int orow_i = lat ? (base - 256 * (oabs0 >> 2) + oabs0 + oo + 64 * rho) : (base + 16 * oo + (rho >> 2) + 64 * (rho & 3));
                const f32x4 v0 = *(const LAS f32x4*)(OT + row * 68 + ch * 8), v1 = *(const LAS f32x4*)(OT + row * 68 + ch * 8 + 4);
                bf16_t* gp = B1 + (size_t)orow_i * 1024 + 512 + jb * 64 + ch * 8;
                const u32x4 g = *(const u32x4*)gp;
                u32x4 w; w.x = pk2(v0[0] * bflo(g.x), v0[1] * bfhi(g.x)); w.y = pk2(v0[2] * bflo(g.y), v0[3] * bfhi(g.y)); w.z = pk2(v1[0] * bflo(g.z), v1[1] * bfhi(g.z)); w.w = pk2(v1[2] * bflo(g.w), v1[3] * bfhi(g.w));
                *(u32x4*)gp = w; }
        }
    }
    __syncthreads();
    if (stage == 0) {
        asm volatile("s_waitcnt vmcnt(0)" ::: "memory");
        __syncthreads();
        if (tid < 64) { __builtin_amdgcn_fence(__ATOMIC_RELEASE, "agent"); asm volatile("s_waitcnt vmcnt(0)" ::: "memory");
            if (tid == 0) for (int it = 0;; ++it) { const int L = it * G + c; if (L >= 1152) break;
                (void)__hip_atomic_fetch_add(cntf + (L < 1024 ? ((L >> 7) * 8 + (L & 7)) : 64 + (L - 1024)), 1u, __ATOMIC_RELAXED, __HIP_MEMORY_SCOPE_AGENT); } }
        __syncthreads();
    }
}

constexpr int AKP = 72;
__device__ __forceinline__ void attn_phase(const Args& a, LAS unsigned char* lds, int layer, int G, int c) {
    int tid = threadIdx.x; asm volatile("" : "+v"(tid));
    const int wave = __builtin_amdgcn_readfirstlane(tid >> 6), lane = tid & 63, cq = lane & 15, qq = lane >> 4;
    const bf16_t* Q = (const bf16_t*)(a.ws + WS_Q); const bf16_t* KV = (const bf16_t*)(a.ws + WS_KV);
    const bf16_t* CK = (const bf16_t*)(a.ws + WS_CK); const bf16_t* CV = (const bf16_t*)(a.ws + WS_CV);
    bf16_t* B1 = (bf16_t*)(a.ws + WS_BUF1);
    LAS bf16_t* KS = (LAS bf16_t*)lds;
    LAS bf16_t* VT = (LAS bf16_t*)(lds + 2 * 64 * AKP * 2);
    const int g = wave >> 1, th = wave & 1;
    const int lkey = tid >> 3, ldc = tid & 7;
    __syncthreads();
    for (int it = 0;; ++it) {
        const int L = it * G + (G - 1 - c); if (L >= 1152) break;
        const bool lat = L < 1024;
        int rowbase, t0, kvh, kstart, nband, ntile, cbase;
        if (lat) { const int b = L >> 7; kvh = (L >> 6) & 1; const int qb = L & 63; rowbase = TP + b * 4096; t0 = qb * 64;
            kstart = t0 - 128 < 0 ? 0 : t0 - 128; const int kend = t0 + 192 > 4096 ? 4096 : t0 + 192; nband = (kend - kstart) >> 6; ntile = nband + 8; cbase = (b * 2 + layer) * 512; }
        else { const int Lc = L - 1024, b = Lc >> 3; kvh = (Lc >> 2) & 1; const int qb = Lc & 3; rowbase = b * 256; t0 = qb * 64; kstart = 0; nband = 4; ntile = 4; cbase = 0; }
        const int h = kvh * 4 + g;
        const float sk = a.sink[layer * 8 + h] * 1.4426950408889634f;
        bf16x8 qf[2][2];
#pragma unroll
        for (int qt = 0; qt < 2; ++qt)
#pragma unroll
            for (int ks = 0; ks < 2; ++ks) qf[qt][ks] = *(const bf16x8*)(Q + (size_t)(rowbase + t0 + 32 * th + 16 * qt + cq) * 512 + h * 64 + 32 * ks + 8 * qq);
        f32x4 o[4][2];
#pragma unroll
        for (int dt = 0; dt < 4; ++dt) { o[dt][0] = (f32x4){0.f, 0.f, 0.f, 0.f}; o[dt][1] = (f32x4){0.f, 0.f, 0.f, 0.f}; }
        float mrun[2] = {sk, sk}, lrun[2] = {qq == 0 ? 1.f : 0.f, qq == 0 ? 1.f : 0.f};
        u32x4 kr, vr;
#define ATT_LOAD(i) do { if ((i) < nband) { const bf16_t* p = KV + (size_t)(rowbase + kstart + 64 * (i) + lkey) * 256 + kvh * 64 + 8 * ldc; kr = *(const u32x4*)p; vr = *(const u32x4*)(p + 128); } \
            else { const size_t off = (size_t)(cbase + 64 * ((i) - nband) + lkey) * 128 + kvh * 64 + 8 * ldc; kr = *(const u32x4*)(CK + off); vr = *(const u32x4*)(CV + off); } } while (0)
#define ATT_STORE(buf) do { *(LAS u32x4*)(KS + (buf) * 64 * AKP + lkey * AKP + 8 * ldc) = kr; \
            *(LAS u32x4*)(VT + (buf) * 64 * AKP + lkey * AKP + 8 * ldc) = vr; } while (0)
        ATT_LOAD(0);
        ATT_STORE(0);
        __syncthreads();
        for (int i = 0; i < ntile; ++i) {
            const int buf = i & 1;
            if (i + 1 < ntile) ATT_LOAD(i + 1);
            const LAS bf16_t* ks_ = KS + buf * 64 * AKP; const LAS bf16_t* vt_ = VT + buf * 64 * AKP;
            f32x4 s[4][2];
#pragma unroll
            for (int kt = 0; kt < 4; ++kt) { s[kt][0] = (f32x4){0.f, 0.f, 0.f, 0.f}; s[kt][1] = (f32x4){0.f, 0.f, 0.f, 0.f};
#pragma unroll
                for (int ks = 0; ks < 2; ++ks) { const bf16x8 kf = *(const LAS bf16x8*)(ks_ + (16 * kt + cq) * AKP + 32 * ks + 8 * qq);
                    s[kt][0] = __builtin_amdgcn_mfma_f32_16x16x32_bf16(kf, qf[0][ks], s[kt][0], 0, 0, 0);
                    s[kt][1] = __builtin_amdgcn_mfma_f32_16x16x32_bf16(kf, qf[1][ks], s[kt][1], 0, 0, 0); } }
            if (lat && i < nband && (kstart + 64 * i < t0 - 64 || kstart + 64 * i > t0 + 64)) {
                const int tkb = kstart + 64 * i + 4 * qq;
#pragma unroll
                for (int qt = 0; qt < 2; ++qt) { const int tq = t0 + 32 * th + 16 * qt + cq;
#pragma unroll
                    for (int kt = 0; kt < 4; ++kt)
#pragma unroll
                        for (int e = 0; e < 4; ++e) { const int d = tq - (tkb + 16 * kt + e); if (d > 128 || d < -128) s[kt][qt][e] = -1e30f; } }
            }
            bf16x8 pf[2][2];
#pragma unroll
            for (int qt = 0; qt < 2; ++qt) {
                float mx = s[0][qt][0];
#pragma unroll
                for (int kt = 0; kt < 4; ++kt)
#pragma unroll
                    for (int e = 0; e < 4; ++e) mx = fmaxf(mx, s[kt][qt][e]);
                mx = fmaxf(mx, __shfl_xor(mx, 16)); mx = fmaxf(mx, __shfl_xor(mx, 32));
                const float mn = fmaxf(mrun[qt], mx), al = __builtin_amdgcn_exp2f(mrun[qt] - mn);
                mrun[qt] = mn; float ls = 0.f;
                float p[4][4];
#pragma unroll
                for (int kt = 0; kt < 4; ++kt)
#pragma unroll
                    for (int e = 0; e < 4; ++e) { p[kt][e] = __builtin_amdgcn_exp2f(s[kt][qt][e] - mn); ls += p[kt][e]; }
                lrun[qt] = lrun[qt] * al + ls;
#pragma unroll
                for (int dt = 0; dt < 4; ++dt) o[dt][qt] = o[dt][qt] * al;
#pragma unroll
                for (int j = 0; j < 2; ++j) { u32x4 w; w.x = cvt_pk(p[2 * j][0], p[2 * j][1]); w.y = cvt_pk(p[2 * j][2], p[2 * j][3]); w.z = cvt_pk(p[2 * j + 1][0], p[2 * j + 1][1]); w.w = cvt_pk(p[2 * j + 1][2], p[2 * j + 1][3]);
                    pf[qt][j] = __builtin_bit_cast(bf16x8, w); }
            }
#pragma unroll
            for (int j = 0; j < 2; ++j)
#pragma unroll
                for (int dt = 0; dt < 4; ++dt) {
                    const LAS bf16_t* vp = vt_ + (32 * j + 4 * qq + (cq >> 2)) * AKP + 16 * dt + 4 * (cq & 3);
                    const v4i16_t t0 = __builtin_amdgcn_ds_read_tr16_b64_v4i16((LAS v4i16_t*)vp), t1 = __builtin_amdgcn_ds_read_tr16_b64_v4i16((LAS v4i16_t*)(vp + 16 * AKP));
                    const bf16x8 vf = (bf16x8){t0[0], t0[1], t0[2], t0[3], t1[0], t1[1], t1[2], t1[3]};
                    o[dt][0] = __builtin_amdgcn_mfma_f32_16x16x32_bf16(vf, pf[0][j], o[dt][0], 0, 0, 0);
                    o[dt][1] = __builtin_amdgcn_mfma_f32_16x16x32_bf16(vf, pf[1][j], o[dt][1], 0, 0, 0); }
            if (i + 1 < ntile) ATT_STORE(buf ^ 1);
            __syncthreads();
        }
#undef ATT_LOAD
#undef ATT_STORE
#pragma unroll
        for (int qt = 0; qt < 2; ++qt) { float lt = lrun[qt]; lt += __shfl_xor(lt, 16); lt += __shfl_xor(lt, 32); const float inv = 1.0f / lt;
            bf16_t* prow = B1 + (size_t)(rowbase + t0 + 32 * th + 16 * qt + cq) * 1024 + h * 64;
#pragma unroll
            for (int k = 0; k < 4; k += 2) {
                float r0[4], r1[4];
#pragma unroll
                for (int e = 0; e < 4; ++e) { const auto r = __builtin_amdgcn_permlane16_swap(__float_as_uint(o[k][qt][e] * inv), __float_as_uint(o[k + 1][qt][e] * inv), false, false);
                    r0[e] = __uint_as_float(r[0]); r1[e] = __uint_as_float(r[1]); }
                bf16_t* p = prow + ((qq & 1) ? 16 * (k + 1) + 4 * (qq - 1) : 16 * k + 4 * qq);
                const u32x4 z = *(const u32x4*)p;
                u32x4 w; w.x = cvt_pk(r0[0] * bflo(z.x), r0[1] * bfhi(z.x)); w.y = cvt_pk(r0[2] * bflo(z.y), r0[3] * bfhi(z.y));
                w.z = cvt_pk(r1[0] * bflo(z.z), r1[1] * bfhi(z.z)); w.w = cvt_pk(r1[2] * bflo(z.w), r1[3] * bfhi(z.w));
                *(u32x4*)p = w; } }
    }
    __syncthreads();
}


#define XB_TMO      128
#define XB_XCNT(j)  (256  + 64 * (j))
#define XB_XSUB(j)  (1280 + 64 * (j))
#define XB_XGEN(j)  (2304 + 64 * (j))
#define XB_TOP      3328
#define XB_TOPGEN   3392
#define XCD_BAR_WORDS 3456
#define XB_SPIN_CAP (1u << 22)
__device__ __forceinline__ unsigned xb_ld(unsigned* p)              { return __hip_atomic_load(p, __ATOMIC_RELAXED, __HIP_MEMORY_SCOPE_AGENT); }
__device__ __forceinline__ unsigned xb_add(unsigned* p, unsigned v) { return __hip_atomic_fetch_add(p, v, __ATOMIC_RELAXED, __HIP_MEMORY_SCOPE_AGENT); }
__device__ __forceinline__ unsigned xb_xcc_id() { return (unsigned)__builtin_amdgcn_s_getreg((3 << 11) | 20) & 0xFu; }
#define XB_SPIN(cond, bar) do { unsigned _sp = 0; while (cond) { __builtin_amdgcn_s_sleep(1); \
    if ((++_sp & 255u) == 0u) { if (xb_ld(&(bar)[XB_TMO])) break; if (_sp > XB_SPIN_CAP) { atomicAdd(&(bar)[XB_TMO], 1u); break; } } } } while (0)
struct XcdBarrier { unsigned* bar; unsigned x; volatile LAS unsigned* st; };
__device__ __forceinline__ XcdBarrier xcd_barrier_post(unsigned* bar, volatile LAS unsigned* st) {
    XcdBarrier b; b.bar = bar; b.x = xb_xcc_id(); b.st = st;
    if (threadIdx.x == 0) (void)xb_add(&bar[XB_XCNT(b.x)], 1u);
    return b;
}
__device__ __forceinline__ void xcd_barrier_complete(unsigned* bar, unsigned x, unsigned& nloc, unsigned& nx) {
    const unsigned G = gridDim.x * gridDim.y * gridDim.z;
    unsigned sum, cnt, mine, sp = 0u;
    for (;;) {
        sum = 0u; cnt = 0u; mine = 0u;
#pragma unroll
        for (unsigned j = 0; j < 16; ++j) { const unsigned c = xb_ld(&bar[XB_XCNT(j)]); sum += c; cnt += (c > 0u) ? 1u : 0u; mine = (j == x) ? c : mine; }
        if (sum == G) break;
        __builtin_amdgcn_s_sleep(1);
        if ((++sp & 255u) == 0u) { if (xb_ld(&bar[XB_TMO])) break; if (sp > XB_SPIN_CAP) { atomicAdd(&bar[XB_TMO], 1u); break; } }
    }
    nloc = mine > 0u ? mine : 1u; nx = cnt > 0u ? cnt : 1u;
}
__device__ __forceinline__ void xcd_barrier(const XcdBarrier& b) {
    asm volatile("s_waitcnt vmcnt(0)" ::: "memory");
    __syncthreads();
    if (threadIdx.x == 0) {
        unsigned* bar = b.bar;
        __builtin_amdgcn_s_waitcnt(0);
        unsigned nloc = b.st[0], nx = b.st[1];
        if (nloc == 0u) { xcd_barrier_complete(bar, b.x, nloc, nx); b.st[0] = nloc; b.st[1] = nx; }
        const unsigned old = xb_add(&bar[XB_XSUB(b.x)], 1u);
        const unsigned gen = old / nloc;
        if (old + 1u == (gen + 1u) * nloc) {
            __builtin_amdgcn_fence(__ATOMIC_RELEASE, "agent");
            asm volatile("s_waitcnt vmcnt(0)" ::: "memory");
            const unsigned og = xb_add(&bar[XB_TOP], 1u);
            const unsigned tg = og / nx;
            if (og + 1u == (tg + 1u) * nx) xb_add(&bar[XB_TOPGEN], 1u);
            else XB_SPIN(xb_ld(&bar[XB_TOPGEN]) == tg, bar);
            __builtin_amdgcn_fence(__ATOMIC_ACQUIRE, "agent");
            xb_add(&bar[XB_XGEN(b.x)], 1u);
            asm volatile("s_waitcnt vmcnt(0)" ::: "memory");
        } else {
            XB_SPIN(xb_ld(&bar[XB_XGEN(b.x)]) == gen, bar);
            __builtin_amdgcn_fence(__ATOMIC_ACQUIRE, "agent");
            asm volatile("s_waitcnt vmcnt(0)" ::: "memory");
        }
    }
    __syncthreads();
}

__global__ void __launch_bounds__(512) mega_fwd(Args a) {
    extern __shared__ __attribute__((aligned(16))) unsigned char lds_raw[];
    LAS unsigned char* lds = (LAS unsigned char*)lds_raw;
    const int G = gridDim.x, c = blockIdx.x;
    unsigned char* ws;
    volatile LAS unsigned* bst = (volatile LAS unsigned*)(lds + LDS_BYTES - 64);
    if (threadIdx.x < 2) bst[threadIdx.x] = 0u;
    __syncthreads();
    XcdBarrier xbar = xcd_barrier_post((unsigned*)(a.ws + WS_BAR), bst);
    for (int ph = a.ph_lo; ph < a.ph_hi; ++ph) {
        if (ph > a.ph_lo) {
            if (a.ph_hi > 1000) {
                cg::this_grid().sync();
            } else {
                xcd_barrier(xbar);
            }
        }
        { size_t z = 0; asm volatile("" : "+s"(z)); ws = a.ws + z; }
#ifndef DBG_MASK
#define DBG_MASK 0xff
#endif
        if (ph == 0) { if (DBG_MASK & 1) phase0(a, lds, G, c); }
        else if (ph == 1) { if (DBG_MASK & 2) ln_phase(a, 0, 0, G, c); }
        else {
            const int l = (ph - 2) / 4, sub = (ph - 2) % 4;
            if (sub == 0) {
                SchedG1 S{(const char*)(ws + WS_H), (const char*)(ws + WS_BT1 + (size_t)l * BT1_L), G, c};
                EpiG1 E{(bf16_t*)(ws + WS_Q), (bf16_t*)(ws + WS_KV), (bf16_t*)(ws + WS_BUF1), (bf16_t*)(ws + WS_BUF2), (bf16_t*)(ws + WS_Z), a.out + OUT_NK, a.out + OUT_NV, l};
                if (DBG_MASK & 4) pg8::gemm_phase<EpiG1, SchedG1>(lds, S, E);
            } else if (sub == 1) {
                unsigned* cntf = (unsigned*)(ws + WS_BAR + 32768) + l * 192;
                if ((c & 1) == 0) conv_phase(a, l, G, c);
                fft_phase(a, lds, 0, G, c, cntf);
                attn_phase(a, lds, l, G, c);
                if (c & 1) conv_phase(a, l, G, c);
                fft_phase(a, lds, 1, G, c, cntf);
            } else if (sub == 2) {
                unsigned* cntl = (unsigned*)(ws + WS_CNT) + l * 144; unsigned* cnt2l = (unsigned*)(ws + WS_CNT2) + l * 1728;
                SchedPG S{(const char*)(ws + WS_BUF1), (const char*)(ws + WS_BUF2), (const char*)(ws + WS_BT2AC + (size_t)l * BT2_L), (const char*)(ws + WS_BT2B + (size_t)l * BT2_L),
                          (const char*)(ws + WS_MG), (const char*)(ws + WS_BT3 + (size_t)l * BT2_L), cntl, G, c, (const char*)(ws + WS_H), (const char*)(ws + WS_BT1G + (size_t)l * BT1G_L)};
                EpiPG E{EpiP{ws, (bf16_t*)(ws + WS_MG)}, EpiOut{a.x_prompt, a.x_sample, a.out, (const float*)(ws + WS_MOD), l}, cntl, cnt2l, ws, (unsigned*)(ws + WS_CNT + 1152) + l * 144, G, c};
                pg8::gemm_phase<EpiPG, SchedPG>(lds, S, E);
            } else {
                ln_phase(a, 1, l, G, c);
            }
        }
    }
}

extern "C" void kernel_launch(void* const* d_in, const int* in_sizes, int n_in, void* d_out, int out_size, void* d_ws, size_t ws_size, hipStream_t stream) {
    static int grid = 0;
    if (grid == 0) {
        if (n_in != 15 || ws_size < WS_END) { fprintf(stderr, "kernel_launch: unexpected n_in %d / ws_size %zu (need %zu)\n", n_in, ws_size, (size_t)WS_END); grid = -1; return; }
        int dev = 0, cus = 0, per_cu = 0;
        if (hipGetDevice(&dev) != hipSuccess || hipDeviceGetAttribute(&cus, hipDeviceAttributeMultiprocessorCount, dev) != hipSuccess) { grid = -1; return; }
        if (hipFuncSetAttribute((const void*)mega_fwd, hipFuncAttributeMaxDynamicSharedMemorySize, LDS_BYTES) != hipSuccess) { fprintf(stderr, "kernel_launch: hipFuncSetAttribute failed\n"); grid = -1; return; }
        if (hipOccupancyMaxActiveBlocksPerMultiprocessor(&per_cu, (const void*)mega_fwd, 512, LDS_BYTES) != hipSuccess || per_cu < 1) { fprintf(stderr, "kernel_launch: occupancy query says %d\n", per_cu); per_cu = 1; }
        (void)hipGetLastError();
        grid = cus * per_cu; if (grid > 256) grid = 256;
        if (grid != 256) { fprintf(stderr, "kernel_launch: this build needs exactly 256 co-resident workgroups, got %d\n", grid); grid = -1; return; }
    }
    if (grid < 0) return;
    Args a{};
    a.x_prompt = (const float*)d_in[0]; a.x_sample = (const float*)d_in[1]; a.cache_k = (const float*)d_in[2]; a.cache_v = (const float*)d_in[3];
    a.c = (const float*)d_in[4]; a.c_ctx = (const float*)d_in[5]; a.w_mod = (const float*)d_in[6]; a.b_mod = (const float*)d_in[7]; a.w_in = (const float*)d_in[8];
    a.sink = (const float*)d_in[9]; a.conv_w = (const float*)d_in[10]; a.w_branch = (const float*)d_in[11]; a.w_o = (const float*)d_in[12]; a.ln_g = (const float*)d_in[13]; a.ln_b = (const float*)d_in[14];
    a.out = (float*)d_out; a.ws = (unsigned char*)d_ws;
#if MK_MULTI
#ifndef RUN_PHASES
#define RUN_PHASES NPHASE
#endif
    for (int ph = 0; ph < RUN_PHASES; ++ph) { a.ph_lo = ph; a.ph_hi = ph + 1; hipLaunchKernelGGL(mega_fwd, dim3(grid), dim3(512), LDS_BYTES, stream, a); }
#else
    a.ph_lo = 0; a.ph_hi = NPHASE;
    (void)hipMemsetAsync((char*)d_ws + WS_BAR, 0, 32768 + 2048, stream);
    void* args[] = {&a};
    hipError_t e = hipLaunchCooperativeKernel((const void*)mega_fwd, dim3(grid), dim3(512), args, LDS_BYTES, stream);
    if (e != hipSuccess) fprintf(stderr, "cooperative launch failed: %s (grid %d)\n", hipGetErrorString(e), grid);
#endif
}
```

```cpp
#include <hip/hip_runtime.h>
#include <hip/hip_cooperative_groups.h>
#include <cstdio>
#include <cstdint>
namespace cg = cooperative_groups;


#ifndef MK_MULTI
#define MK_MULTI 0
#endif

#define LAS __attribute__((address_space(3)))
typedef unsigned short bf16_t;
typedef short bf16x8 __attribute__((ext_vector_type(8)));
typedef short s16x4 __attribute__((ext_vector_type(4)));
typedef float f32x4 __attribute__((ext_vector_type(4)));
typedef unsigned u32x4 __attribute__((ext_vector_type(4)));
typedef unsigned u32x2 __attribute__((ext_vector_type(2)));

constexpr int DM = 1024, TP = 4096, TS = 32768, TT = TP + TS;
constexpr int INW = 7424;
constexpr int NT1 = 19;
constexpr size_t MiB = 1u << 20;
constexpr size_t WS_MOD = 0, WS_FMAT = 1 * MiB, WS_BT1 = 2 * MiB, WS_BT1G = 21 * MiB, WS_BT2AC = 33 * MiB, WS_BT2B = 37 * MiB, WS_BT3 = 41 * MiB,
                 WS_CK = 45 * MiB, WS_CV = 47 * MiB, WS_H = 49 * MiB  , WS_MG = WS_H,
                 WS_Q = 121 * MiB  , WS_KV = 157 * MiB, WS_BUF1 = 193 * MiB,
                 WS_BUF2 = 265 * MiB, WS_Z = 337 * MiB  , WS_GT2 = 409 * MiB, WS_END = 481 * MiB;
constexpr size_t WS_BAR = 512 * 1024;
constexpr size_t WS_CNT = WS_BAR + 16384;
constexpr size_t WS_CNT2 = WS_BAR + 18432;
constexpr size_t BT1_L = (size_t)NT1 * 256 * 1024 * 2, BT1G_L = (size_t)3072 * 1024 * 2, BT2_L = (size_t)1024 * 1024 * 2;
constexpr int LDS_BYTES = 147456;
constexpr int NPHASE = 10;
constexpr size_t OUT_NK = (size_t)TT * DM, OUT_NV = OUT_NK + (size_t)16 * 2 * 256 * 128;

struct Args {
    const float *x_prompt, *x_sample, *cache_k, *cache_v, *c, *c_ctx, *w_mod, *b_mod, *w_in, *sink, *conv_w, *w_branch, *w_o, *ln_g, *ln_b;
    float* out; unsigned char* ws; int ph_lo, ph_hi;
};

__device__ __forceinline__ float bflo(unsigned w) { return __uint_as_float(w << 16); }
__device__ __forceinline__ float bfhi(unsigned w) { return __uint_as_float(w & 0xffff0000u); }
__device__ __forceinline__ float bf1(unsigned short h) { return __uint_as_float((unsigned)h << 16); }
__device__ __forceinline__ unsigned f2bf(float f) { unsigned u = __float_as_uint(f); return (u + 0x7fffu + ((u >> 16) & 1u)) >> 16; }
__device__ __forceinline__ unsigned pk2(float lo, float hi) { return f2bf(lo) | (f2bf(hi) << 16); }
typedef float f32x2_t __attribute__((ext_vector_type(2))); typedef __bf16 bf16x2_t __attribute__((ext_vector_type(2)));
__device__ __forceinline__ unsigned cvt_pk(float lo, float hi) { f32x2_t v = {lo, hi}; bf16x2_t b = __builtin_convertvector(v, bf16x2_t); return __builtin_bit_cast(unsigned, b); }
__device__ __forceinline__ float silu_f(float x) { return x * __builtin_amdgcn_rcpf(1.0f + __expf(-x)); }
__device__ __forceinline__ float sigm_f(float x) { return __builtin_amdgcn_rcpf(1.0f + __expf(-x)); }
template <int CTRL> __device__ __forceinline__ float dpp_f(float v) { return __int_as_float(__builtin_amdgcn_update_dpp(0, __float_as_int(v), CTRL, 0xf, 0xf, false)); }
__device__ __forceinline__ float wave_sum(float v) {
    v += dpp_f<0xB1>(v);
    v += dpp_f<0x4E>(v);
    v += dpp_f<0x141>(v);
    v += dpp_f<0x140>(v);
    v += __shfl_xor(v, 16); v += __shfl_xor(v, 32);
    return v;
}
__device__ __forceinline__ int cond_of_row(int m) { return m < TP ? 0 : 1 + ((m - TP) >> 12); }

namespace pg8 {
constexpr int BM = 256, BK = 64, HALF = 128, HTB = HALF * BK * 2, STAGE_BYTES = 8 * HTB, KP = 1024;
constexpr size_t TSTEP = (size_t)BM * KP * 2;
__device__ __forceinline__ int lds_byte(int r, int c) { const int st = (r >> 4) * 2 + (c >> 5), rr = r & 15, cc = c & 31, ob = rr * 64 + cc * 2; return st * 1024 + (ob ^ (((ob >> 9) & 1) << 5)); }
__device__ __forceinline__ void stage_rc(int b, int& R, int& C) { const int st = b / 1024, sb = b % 1024, swz = sb ^ (((sb >> 9) & 1) << 5); R = (st >> 1) * 16 + swz / 64; C = (st & 1) * 32 + (swz % 64) / 2; }

struct Unit { int pm, pn, kind, nt; const char* a; const char* b; };

template <class Epi, class Sched>
__device__ __forceinline__ void gemm_phase(LAS unsigned char* lds, const Sched& S, const Epi& E) {
    int tid = threadIdx.x; asm volatile("" : "+v"(tid));
    const int wid = __builtin_amdgcn_readfirstlane(tid >> 6), lane = tid & 63, wr = wid >> 2, wc = wid & 3, fr = lane & 15, fq = lane >> 4;
    unsigned voff[2];
#pragma unroll
    for (int i = 0; i < 2; ++i) { int R, C; stage_rc(tid * 16 + i * 8192, R, C); voff[i] = (unsigned)(R * KP + C) * 2u; }
    constexpr size_t kstep = (size_t)(BK * 2);
    constexpr size_t hstep = (size_t)HALF * KP * 2;
    const unsigned ldsw = (unsigned)wid * 1024u;
    const int aoff = lds_byte(wr * 64 + fr, fq * 8), boff = lds_byte(wc * 32 + fr, fq * 8);
#define PG8_SA(b, h) (((b) * 2 + (h)) * HTB)
#define PG8_SB(b, h) ((4 + (b) * 2 + (h)) * HTB)
#define PG8_STAGE(bufoff, gbase) do { _Pragma("unroll") for (int _i = 0; _i < 2; ++_i) \
        __builtin_amdgcn_global_load_lds((const unsigned*)((const char*)(gbase) + voff[_i]), (LAS unsigned*)(lds + (bufoff) + ldsw + _i * 8192), 16, 0, 0); } while (0)
#define PG8_LDA(dst, b, h) do { _Pragma("unroll") for (int m = 0; m < 4; ++m) _Pragma("unroll") for (int k = 0; k < 2; ++k) dst[m][k] = *(const LAS bf16x8*)(lds + PG8_SA(b, h) + aoff + m * 2048 + k * 1024); } while (0)
#define PG8_LDB(dst, b, h) do { _Pragma("unroll") for (int n = 0; n < 2; ++n) _Pragma("unroll") for (int k = 0; k < 2; ++k) dst[n][k] = *(const LAS bf16x8*)(lds + PG8_SB(b, h) + boff + n * 2048 + k * 1024); } while (0)
#define PG8_MMA(ai, bj, At, Bt) do { __builtin_amdgcn_s_setprio(1); _Pragma("unroll") for (int m = 0; m < 4; ++m) _Pragma("unroll") for (int n = 0; n < 2; ++n) _Pragma("unroll") for (int k = 0; k < 2; ++k) \
        acc[ai][bj][m][n] = __builtin_amdgcn_mfma_f32_16x16x32_bf16(Bt[n][k], At[m][k], acc[ai][bj][m][n], 0, 0, 0); __builtin_amdgcn_s_setprio(0); } while (0)
#define PG8_WAIT_V(n) asm volatile("s_waitcnt vmcnt(" #n ")" ::: "memory")
#define PG8_WAIT_L(n) asm volatile("s_waitcnt lgkmcnt(" #n ")" ::: "memory")
#define PG8_BAR __builtin_amdgcn_s_barrier()
#define PG8_SCHED __builtin_amdgcn_sched_barrier(0)
    Unit cur, nxt; int ui = 0;
    if (!S.next(0, cur)) return;
    f32x4 acc[2][2][4][2];
#pragma unroll
    for (int a = 0; a < 2; ++a)
#pragma unroll
        for (int b = 0; b < 2; ++b)
#pragma unroll
            for (int m = 0; m < 4; ++m)
#pragma unroll
                for (int n = 0; n < 2; ++n) acc[a][b][m][n] = (f32x4){0.f, 0.f, 0.f, 0.f};
    bf16x8 At[4][2], B0[2][2], B1[2][2];
    const char* cA = cur.a; const char* cB = cur.b;
    PG8_STAGE(PG8_SB(0, 0), cB); PG8_STAGE(PG8_SB(0, 1), cB + hstep); PG8_STAGE(PG8_SA(0, 0), cA); PG8_STAGE(PG8_SA(0, 1), cA + hstep);
    if (wr == 1) PG8_BAR;
    PG8_WAIT_V(2); PG8_BAR;
    PG8_STAGE(PG8_SB(1, 0), cB + kstep); PG8_STAGE(PG8_SA(1, 0), cA + kstep); PG8_STAGE(PG8_SB(1, 1), cB + hstep + kstep);
    PG8_WAIT_V(6); PG8_BAR;
    for (;;) {
        const bool has_next = S.next(ui + 1, nxt);
        const char* nA = has_next ? nxt.a : cA; const char* nB = has_next ? nxt.b : cB;
        const int nt = cur.nt;
        for (int t = 0; t < nt; t += 2) {
            const bool last = (t == nt - 2);
            const char* a1 = cA + (size_t)(t + 1) * kstep;
            const char* a2 = last ? nA : cA + (size_t)(t + 2) * kstep; const char* b2 = last ? nB : cB + (size_t)(t + 2) * kstep;
            const char* a3 = a2 + kstep; const char* b3 = b2 + kstep;
            if (last && has_next) S.a_ready(nxt);
            PG8_LDB(B0, 0, 0); PG8_LDB(B1, 0, 1); PG8_SCHED; PG8_LDA(At, 0, 0); PG8_STAGE(PG8_SA(1, 1), a1 + hstep);
            PG8_WAIT_V(8); PG8_WAIT_L(0); PG8_BAR; PG8_MMA(0, 0, At, B0); PG8_MMA(0, 1, At, B1); PG8_BAR; PG8_SCHED;
            PG8_LDA(At, 0, 1); PG8_STAGE(PG8_SB(0, 0), b2); PG8_STAGE(PG8_SB(0, 1), b2 + hstep); PG8_STAGE(PG8_SA(0, 0), a2);
            PG8_WAIT_V(8); PG8_WAIT_L(0); PG8_BAR; PG8_MMA(1, 0, At, B0); PG8_MMA(1, 1, At, B1); PG8_BAR; PG8_SCHED;
            PG8_LDB(B0, 1, 0); PG8_LDB(B1, 1, 1); PG8_SCHED; PG8_LDA(At, 1, 0); PG8_STAGE(PG8_SA(0, 1), a2 + hstep);
            PG8_WAIT_V(8); PG8_WAIT_L(0); PG8_BAR; PG8_MMA(0, 0, At, B0); PG8_MMA(0, 1, At, B1); PG8_BAR; PG8_SCHED;
            PG8_LDA(At, 1, 1); PG8_STAGE(PG8_SB(1, 0), b3); PG8_STAGE(PG8_SB(1, 1), b3 + hstep); PG8_STAGE(PG8_SA(1, 0), a3);
            PG8_WAIT_V(8); PG8_WAIT_L(0); PG8_BAR; PG8_MMA(1, 0, At, B0); PG8_MMA(1, 1, At, B1); PG8_BAR; PG8_SCHED;
        }
        if (wr == 0) PG8_BAR;
        E(acc, cur, wr, wc, fr, fq);
        if (!has_next) break;
#pragma unroll
        for (int a = 0; a < 2; ++a)
#pragma unroll
            for (int b = 0; b < 2; ++b)
#pragma unroll
                for (int m = 0; m < 4; ++m)
#pragma unroll
                    for (int n = 0; n < 2; ++n) acc[a][b][m][n] = (f32x4){0.f, 0.f, 0.f, 0.f};
        cur = nxt; cA = nA; cB = nB; ++ui;
        if (wr == 1) PG8_BAR;
    }
    PG8_WAIT_V(0);
    PG8_BAR;
#undef PG8_SA
#undef PG8_SB
#undef PG8_STAGE
#undef PG8_LDA
#undef PG8_LDB
#undef PG8_MMA
#undef PG8_WAIT_V
#undef PG8_WAIT_L
#undef PG8_BAR
#undef PG8_SCHED
}
}
using pg8::Unit;

enum { K_Q = 0, K_KV = 1, K_ZA = 2, K_CONV = 3, K_Z = 4, K_ZC = 5, K_GATE = 6, K_P = 7, K_OUT = 8 };
struct SchedG1 {
    const char* A; const char* B; int G, c;
    __device__ __forceinline__ void a_ready(const Unit&) const {}
    __device__ __forceinline__ bool next(int i, Unit& u) const {
        constexpr int nM = TT / 256, nN = NT1, nwg = nM * nN, NXCD = 8, WGM = 8;
        const long L = (long)i * G + c; if (L >= nwg) return false;
        int wgid = (int)L; { const int q = nwg / NXCD, r = nwg % NXCD, xcd = wgid % NXCD, off = wgid / NXCD; wgid = (xcd < r ? xcd * (q + 1) : r * (q + 1) + (xcd - r) * q) + off; }
        const int nig = WGM * nN, gid = wgid / nig, fm = gid * WGM, gsz = (nM - fm) < WGM ? (nM - fm) : WGM;
        const int pm = fm + ((wgid % nig) % gsz), pn = (wgid % nig) / gsz;
        u.pm = pm; u.pn = pn; u.nt = 16;
        u.kind = pn < 2 ? K_Q : pn == 2 ? K_KV : pn < 5 ? K_ZA : pn < 13 ? K_CONV : pn < 17 ? K_Z : K_ZC;
        u.a = A + (size_t)pm * pg8::TSTEP; u.b = B + (size_t)pn * pg8::TSTEP; return true;
    }
};
__device__ __forceinline__ bool tile_of(int j, int G, int c, int& pm, int& pn) {
    if (G != 256) { const int L = j * G + c; if (L >= 576) return false; pm = L >> 2; pn = L & 3; return true; }
    const int xcd = c & 7, slot = c >> 3;
    if (j < 2) { pm = j * 64 + xcd * 8 + (slot >> 2); pn = slot & 3; return true; }
    if (j == 2 && slot < 8) { pm = 128 + 2 * xcd + (slot >> 2); pn = slot & 3; return true; }
    return false;
}
struct SchedGate {
    const char* A; const char* B; int G, c;
    __device__ __forceinline__ void a_ready(const Unit&) const {}
    __device__ __forceinline__ bool next(int i, Unit& u) const {
        constexpr int nM = TT / 256, nN = 12, nwg = nM * nN, NXCD = 8, WGM = 8;
        const long L = (long)i * G + c; if (L >= nwg) return false;
        int wgid = (int)L; { const int q = nwg / NXCD, r = nwg % NXCD, xcd = wgid % NXCD, off = wgid / NXCD; wgid = (xcd < r ? xcd * (q + 1) : r * (q + 1) + (xcd - r) * q) + off; }
        const int nig = WGM * nN, gid = wgid / nig, fm = gid * WGM, gsz = (nM - fm) < WGM ? (nM - fm) : WGM;
        const int pm = fm + ((wgid % nig) % gsz), pn = (wgid % nig) / gsz;
        u.pm = pm; u.pn = pn; u.nt = 16; u.kind = K_GATE;
        u.a = A + (size_t)pm * pg8::TSTEP; u.b = B + (size_t)pn * pg8::TSTEP; return true;
    }
};
struct SchedP {
    const char *B1, *B2, *Wac, *Wb; int G, c;
    __device__ __forceinline__ void a_ready(const Unit&) const {}
    __device__ __forceinline__ bool next(int i, Unit& u) const {
        const int j = i / 3, b = i - 3 * j; int pm, pn;
        if (!tile_of(j, G, c, pm, pn)) return false;
        u.pm = pm; u.pn = pn | (b << 4); u.kind = K_P; u.nt = 8;
        u.a = (b == 1 ? B2 : B1) + (size_t)pm * pg8::TSTEP + (b == 2 ? 1024 : 0);
        u.b = (b == 1 ? Wb : Wac) + (size_t)pn * pg8::TSTEP + (b == 2 ? 1024 : 0);
        return true;
    }
};
struct SchedG3 {
    const char* A; const char* B; int G, c;
    __device__ __forceinline__ void a_ready(const Unit&) const {}
    __device__ __forceinline__ bool next(int i, Unit& u) const {
        int pm, pn; if (!tile_of(i, G, c, pm, pn)) return false;
        u.pm = pm; u.pn = pn; u.kind = K_OUT; u.nt = 16; u.a = A + (size_t)u.pm * pg8::TSTEP; u.b = B + (size_t)u.pn * pg8::TSTEP; return true;
    }
};

__device__ __forceinline__ void st4bf(bf16_t* p, float a, float b, float c, float d) { u32x2 w; w.x = cvt_pk(a, b); w.y = cvt_pk(c, d); *(u32x2*)p = w; }

__device__ __forceinline__ void st8bf_swap(bf16_t* p_even, bf16_t* p_odd, u32x2 w0, u32x2 w1, int fq) {
    const auto rx = __builtin_amdgcn_permlane16_swap(w0.x, w1.x, false, false);
    const auto ry = __builtin_amdgcn_permlane16_swap(w0.y, w1.y, false, false);
    u32x4 o; o.x = rx[0]; o.y = ry[0]; o.z = rx[1]; o.w = ry[1];
    *(u32x4*)((fq & 1) ? p_odd : p_even) = o;
}
__device__ __forceinline__ u32x2 pk4(float a, float b, float c, float d) { u32x2 w; w.x = cvt_pk(a, b); w.y = cvt_pk(c, d); return w; }

struct EpiG1 {
    bf16_t *Q, *KV, *B1, *B2, *Z; float* newk; float* newv; int layer;
    __device__ __forceinline__ void operator()(const f32x4 (&acc)[2][2][4][2], const Unit& u, int wr, int wc, int fr, int fq) const {
        const int row0 = u.pm * 256 + wr * 64 + fr;
        const int kind = u.kind;
        if (kind == K_Q || kind == K_KV) {
            const bool lat = u.pm >= 16;
            float invf[4];
#pragma unroll
            for (int j = 0; j < 4; ++j) invf[j] = exp2f(-(float)(4 * fq + j) * 0.83048202372184f);
            const int seg = wc & 1;
#pragma unroll
            for (int ai = 0; ai < 2; ++ai)
#pragma unroll
                for (int m = 0; m < 4; ++m) {
                    const int r = row0 + ai * 128 + m * 16;
                    float cs[4], sn[4];
                    if (lat) { const int tok = (r - TP) & 4095; const float pos = (float)(seg ? (tok & 63) : (tok >> 6));
#pragma unroll
                        for (int j = 0; j < 4; ++j) { const float ang = pos * invf[j]; cs[j] = __cosf(ang); sn[j] = __sinf(ang); } }
                    else {
#pragma unroll
                        for (int j = 0; j < 4; ++j) { cs[j] = 1.f; sn[j] = 0.f; } }
                    if (kind == K_Q) {
#pragma unroll
                        for (int bj = 0; bj < 2; ++bj) { const f32x4 x1 = acc[ai][bj][m][0], x2 = acc[ai][bj][m][1]; float o1[4], o2[4];
#pragma unroll
                            for (int j = 0; j < 4; ++j) { o1[j] = (x1[j] * cs[j] - x2[j] * sn[j]) * 0.18033688011112042f; o2[j] = (x2[j] * cs[j] + x1[j] * sn[j]) * 0.18033688011112042f; }
                            bf16_t* p = Q + (size_t)r * 512 + u.pn * 256 + bj * 128 + wc * 32 + 4 * fq;
                            st8bf_swap(p, p + 12, pk4(o1[0], o1[1], o1[2], o1[3]), pk4(o2[0], o2[1], o2[2], o2[3]), fq); }
                    } else {
                        { const f32x4 x1 = acc[ai][0][m][0], x2 = acc[ai][0][m][1]; float o1[4], o2[4];
#pragma unroll
                            for (int j = 0; j < 4; ++j) { o1[j] = x1[j] * cs[j] - x2[j] * sn[j]; o2[j] = x2[j] * cs[j] + x1[j] * sn[j]; }
                            bf16_t* p = KV + (size_t)r * 256 + wc * 32 + 4 * fq;
                            st8bf_swap(p, p + 12, pk4(o1[0], o1[1], o1[2], o1[3]), pk4(o2[0], o2[1], o2[2], o2[3]), fq);
                            if (!lat) { float* o = newk + ((size_t)((r >> 8) * 2 + layer) * 256 + (r & 255)) * 128 + wc * 32 + 4 * fq; *(f32x4*)o = x1; *(f32x4*)(o + 16) = x2; } }
                        { const f32x4 v1 = acc[ai][1][m][0], v2 = acc[ai][1][m][1];
                            bf16_t* p = KV + (size_t)r * 256 + 128 + wc * 32 + 4 * fq;
                            st8bf_swap(p, p + 12, pk4(v1[0], v1[1], v1[2], v1[3]), pk4(v2[0], v2[1], v2[2], v2[3]), fq);
                            if (!lat) { float* o = newv + ((size_t)((r >> 8) * 2 + layer) * 256 + (r & 255)) * 128 + wc * 32 + 4 * fq; *(f32x4*)o = v1; *(f32x4*)(o + 16) = v2; } }
                    }
                }
        } else if (kind == K_CONV) {
            const int t = u.pn - 5; const bool wt = t < 4;
            const int ch = 128 * (t & 3) + 32 * wc + 4 * fq + (wt ? 0 : 512);
#pragma unroll
            for (int ai = 0; ai < 2; ++ai)
#pragma unroll
                for (int m = 0; m < 4; ++m) {
                    const int r = row0 + ai * 128 + m * 16;
                    u32x2 w[2];
#pragma unroll
                    for (int n = 0; n < 2; ++n) { const f32x4 a0 = acc[ai][0][m][n], a1 = acc[ai][1][m][n];
                        w[n] = wt ? pk4(a0[0] * silu_f(a1[0]), a0[1] * silu_f(a1[1]), a0[2] * silu_f(a1[2]), a0[3] * silu_f(a1[3])) : pk4(a0[0] * a1[0], a0[1] * a1[1], a0[2] * a1[2], a0[3] * a1[3]); }
                    bf16_t* p = B2 + (size_t)r * 1024 + ch;
                    st8bf_swap(p, p + 12, w[0], w[1], fq);
                }
        } else {
#ifdef TEST_NOZ
            if (kind == K_Z) return;
#endif
            bf16_t* base; int colt; const bool act = (kind != K_Z);
            if (kind == K_ZA) { base = B1; colt = (u.pn - 3) * 256; } else if (kind == K_Z) { base = Z; colt = (u.pn - 13) * 256; } else { base = B1; colt = 512 + (u.pn - 17) * 256; }
#pragma unroll
            for (int ai = 0; ai < 2; ++ai)
#pragma unroll
                for (int m = 0; m < 4; ++m) {
                    const int r = row0 + ai * 128 + m * 16;
#pragma unroll
                    for (int bj = 0; bj < 2; ++bj) { f32x4 v0 = acc[ai][bj][m][0], v1 = acc[ai][bj][m][1];
                            if (act) { v0[0] = silu_f(v0[0]); v0[1] = silu_f(v0[1]); v0[2] = silu_f(v0[2]); v0[3] = silu_f(v0[3]); v1[0] = silu_f(v1[0]); v1[1] = silu_f(v1[1]); v1[2] = silu_f(v1[2]); v1[3] = silu_f(v1[3]); }
                            bf16_t* pp = base + (size_t)r * 1024 + colt + bj * 128 + wc * 32 + 4 * fq;
                            st8bf_swap(pp, pp + 12, pk4(v0[0], v0[1], v0[2], v0[3]), pk4(v1[0], v1[1], v1[2], v1[3]), fq); }
                }
        }
    }
};

struct EpiGate {
    unsigned char* wsb; float* dbg_out;
    __device__ __forceinline__ void operator()(const f32x4 (&acc)[2][2][4][2], const Unit& u, int wr, int wc, int fr, int fq) const {
        const int b = u.pn >> 2, pn = u.pn & 3;
        int tid = threadIdx.x; asm volatile("" : "+v"(tid));
        const size_t goff = b == 0 ? WS_Z : (b == 1 ? WS_Q : WS_GT2);
        u32x2* blk = (u32x2*)(wsb + goff) + (size_t)(u.pm * 4 + pn) * 16384 + tid;
#pragma unroll
        for (int ai = 0; ai < 2; ++ai)
#pragma unroll
            for (int bj = 0; bj < 2; ++bj)
#pragma unroll
                for (int m = 0; m < 4; ++m)
#pragma unroll
                    for (int n = 0; n < 2; ++n) { const f32x4 v = acc[ai][bj][m][n]; u32x2 w; w.x = cvt_pk(sigm_f(v[0]), sigm_f(v[1])); w.y = cvt_pk(sigm_f(v[2]), sigm_f(v[3]));
                        blk[(((ai * 2 + bj) * 4 + m) * 2 + n) * 512] = w; }
    }
};
struct EpiP {
    unsigned char* wsb; bf16_t* MG;
    __device__ __forceinline__ void operator()(const f32x4 (&acc)[2][2][4][2], const Unit& u, int wr, int wc, int fr, int fq) const {
        const int pn = u.pn & 3, b = u.pn >> 4;
        int tid = threadIdx.x; asm volatile("" : "+v"(tid));
        const size_t tb = (size_t)(u.pm * 4 + pn) * 8192 + tid;
        const u32x4* gblk = (const u32x4*)(wsb + (b == 0 ? WS_Z : (b == 1 ? WS_Q : WS_GT2))) + tb;
        u32x4* sblk = (u32x4*)(wsb + WS_Z) + tb;
        const size_t off0 = (size_t)(u.pm * 256 + wr * 64 + fr) * 1024 + pn * 256 + wc * 32 + 4 * fq;
        constexpr int DEPTH = 3;
        u32x4 gq[8][2], oq[8][2];
#define EPIP_LOAD(gi) do { _Pragma("unroll") for (int bj = 0; bj < 2; ++bj) { const int ps = (((gi) >> 2) * 2 + bj) * 4 + ((gi) & 3); \
            gq[gi][bj] = gblk[ps * 512]; oq[gi][bj] = (u32x4){0u, 0u, 0u, 0u}; if (b > 0) oq[gi][bj] = sblk[ps * 512]; } } while (0)
#pragma unroll
        for (int gi = 0; gi < DEPTH; ++gi) EPIP_LOAD(gi);
#pragma unroll
        for (int gi = 0; gi < 8; ++gi) {
            const int ai = gi >> 2, m = gi & 3;
            if (gi + DEPTH < 8) EPIP_LOAD(gi + DEPTH);
#pragma unroll
            for (int bj = 0; bj < 2; ++bj) {
                const f32x4 v0 = acc[ai][bj][m][0], v1 = acc[ai][bj][m][1]; const u32x4 g = gq[gi][bj], o = oq[gi][bj];
                const float a0 = bflo(g.x) * v0[0] + bflo(o.x), a1 = bfhi(g.x) * v0[1] + bfhi(o.x), a2 = bflo(g.y) * v0[2] + bflo(o.y), a3 = bfhi(g.y) * v0[3] + bfhi(o.y);
                const float c0 = bflo(g.z) * v1[0] + bflo(o.z), c1 = bfhi(g.z) * v1[1] + bfhi(o.z), c2 = bflo(g.w) * v1[2] + bflo(o.w), c3 = bfhi(g.w) * v1[3] + bfhi(o.w);
                if (b == 2) { bf16_t* p = MG + off0 + (size_t)(ai * 128 + m * 16) * 1024 + bj * 128;
                    __hip_atomic_store((unsigned long long*)p, (unsigned long long)cvt_pk(a0, a1) | ((unsigned long long)cvt_pk(a2, a3) << 32), __ATOMIC_RELAXED, __HIP_MEMORY_SCOPE_AGENT);
                    __hip_atomic_store((unsigned long long*)(p + 16), (unsigned long long)cvt_pk(c0, c1) | ((unsigned long long)cvt_pk(c2, c3) << 32), __ATOMIC_RELAXED, __HIP_MEMORY_SCOPE_AGENT); }
                else { u32x4 w; w.x = cvt_pk(a0, a1); w.y = cvt_pk(a2, a3); w.z = cvt_pk(c0, c1); w.w = cvt_pk(c2, c3); sblk[((ai * 2 + bj) * 4 + m) * 512] = w; }
            }
        }
#undef EPIP_LOAD
    }
};

struct EpiOut {
    const float *xp, *xs; float* Y; const float* mod; int layer;
    __device__ __forceinline__ void operator()(const f32x4 (&acc)[2][2][4][2], const Unit& u, int wr, int wc, int fr, int fq) const {
        const float* xin = layer == 0 ? (u.pm < 16 ? xp : xs - (size_t)TP * DM) : Y;
        const int cond = u.pm < 16 ? 0 : 1 + ((u.pm - 16) >> 4);
        const float* gp = mod + (size_t)(layer * 9 + cond) * 3072 + 2048 + u.pn * 256 + wc * 32 + 4 * fq;
        const size_t off0 = (size_t)(u.pm * 256 + wr * 64 + fr) * DM + u.pn * 256 + wc * 32 + 4 * fq;
        constexpr int DEPTH = 3;
        f32x4 gv[4], xq[8][4];
#define EPIO_LOAD(gi) do { _Pragma("unroll") for (int q = 0; q < 4; ++q) xq[gi][q] = __builtin_nontemporal_load((const f32x4*)(xin + off0 + (size_t)((((gi) >> 2) * 128) + ((gi) & 3) * 16) * DM + (q >> 1) * 128 + (q & 1) * 16)); } while (0)
#pragma unroll
        for (int q = 0; q < 4; ++q) gv[q] = *(const f32x4*)(gp + (q >> 1) * 128 + (q & 1) * 16);
#pragma unroll
        for (int gi = 0; gi < DEPTH; ++gi) EPIO_LOAD(gi);
#pragma unroll
        for (int gi = 0; gi < 8; ++gi) {
            const int ai = gi >> 2, m = gi & 3;
            if (gi + DEPTH < 8) EPIO_LOAD(gi + DEPTH);
#pragma unroll
            for (int q = 0; q < 4; ++q) *(f32x4*)(Y + off0 + (size_t)(ai * 128 + m * 16) * DM + (q >> 1) * 128 + (q & 1) * 16) = xq[gi][q] * 1.41421356237f + gv[q] * acc[ai][q >> 1][m][q & 1];
        }
#undef EPIO_LOAD
    }
};


struct SchedPG {
    const char *B1, *B2, *Wac, *Wb, *MGp, *W3; unsigned* cnt; int G, c; const char *Hp, *Wg;
    __device__ __forceinline__ bool next(int i0, Unit& u) const {
        const int cr = G - 1 - c;
        if (i0 < 7) { SchedGate sg{Hp, Wg, G, cr}; if (sg.next(i0, u)) { if (i0 == (cr < 192 ? 6 : 5)) u.pn |= 0x100; return true; } }
        const int i = i0 - (cr < 192 ? 7 : 6);
        const int x = c & 7, s = c >> 3, nch = s < 8 ? 3 : 2;
        if (i < 3 * nch) {
            const int j = i / 3, b = i - 3 * j; int pm, pn; (void)tile_of(j, G, c, pm, pn);
            u.pm = pm; u.pn = pn | (b << 4); u.kind = K_P; u.nt = 8;
            u.a = (b == 1 ? B2 : B1) + (size_t)pm * pg8::TSTEP + (b == 2 ? 1024 : 0);
            u.b = (b == 1 ? Wb : Wac) + (size_t)pn * pg8::TSTEP + (b == 2 ? 1024 : 0);
            return true;
        }
        const int k = i - 3 * nch, nG = s < 8 ? 1 : (s < 24 ? 3 : 2);
        if (k >= nG) return false;
        int pm, pn;
        if (k == 0) { pm = x * 8 + (s >> 2); pn = s & 3; }
        else { const int uu = (k == 1) ? (s - 8) : (24 + s - 8);
            if (uu < 32) { pm = 64 + x * 8 + (uu >> 2); pn = uu & 3; } else { pm = 128 + 2 * x + ((uu - 32) >> 2); pn = (uu - 32) & 3; } }
        u.pm = pm; u.pn = pn; u.kind = K_OUT; u.nt = 16; u.a = MGp + (size_t)pm * pg8::TSTEP; u.b = W3 + (size_t)pn * pg8::TSTEP; return true;
    }
    __device__ __forceinline__ void a_ready(const Unit& n) const {
        if (n.kind != K_OUT) return;
        unsigned* p = cnt + n.pm; unsigned sp = 0;
        while (__hip_atomic_load(p, __ATOMIC_RELAXED, __HIP_MEMORY_SCOPE_AGENT) < 32u) { __builtin_amdgcn_s_sleep(2); if (++sp > (1u << 21)) break; }
        asm volatile("s_waitcnt vmcnt(0)" ::: "memory");
    }
};
struct EpiPG {
    EpiP ep; EpiOut eo; unsigned* cnt; unsigned* cnt2; unsigned char* wsb; unsigned* cnt3; int Gw, cw;
    __device__ __forceinline__ void operator()(const f32x4 (&acc)[2][2][4][2], const Unit& u, int wr, int wc, int fr, int fq) const {
        if (u.kind == K_GATE) {
            const int pn12 = u.pn & 0xff, b = pn12 >> 2, pn = pn12 & 3;
            int tid = threadIdx.x; asm volatile("" : "+v"(tid));
            const size_t goff = b == 0 ? WS_Z : (b == 1 ? WS_Q : WS_GT2);
            u32x4* blk = (u32x4*)(wsb + goff) + (size_t)(u.pm * 4 + pn) * 8192 + tid;
#pragma unroll
            for (int ai = 0; ai < 2; ++ai)
#pragma unroll
                for (int bj = 0; bj < 2; ++bj)
#pragma unroll
                    for (int m = 0; m < 4; ++m) { const f32x4 v0 = acc[ai][bj][m][0], v1 = acc[ai][bj][m][1]; u32x4 w;
                        w.x = cvt_pk(sigm_f(v0[0]), sigm_f(v0[1])); w.y = cvt_pk(sigm_f(v0[2]), sigm_f(v0[3])); w.z = cvt_pk(sigm_f(v1[0]), sigm_f(v1[1])); w.w = cvt_pk(sigm_f(v1[2]), sigm_f(v1[3]));
                        blk[((ai * 2 + bj) * 4 + m) * 512] = w; }
            if (u.pn & 0x100) {
                asm volatile("s_waitcnt vmcnt(0)" ::: "memory");
                __builtin_amdgcn_s_barrier();
                if (threadIdx.x < 64) {
                    __builtin_amdgcn_fence(__ATOMIC_RELEASE, "agent");
                    asm volatile("s_waitcnt vmcnt(0)" ::: "memory");
                    if (threadIdx.x == 0) { const int cr = Gw - 1 - cw; SchedGate sg{nullptr, nullptr, Gw, cr}; Unit t;
                        for (int i = 0; i < 7; ++i) { if (!sg.next(i, t)) break;
                            (void)__hip_atomic_fetch_add(cnt2 + (t.pm * 4 + (t.pn & 3)) * 3 + (t.pn >> 2), 8u, __ATOMIC_RELAXED, __HIP_MEMORY_SCOPE_AGENT);
                            (void)__hip_atomic_fetch_add(cnt3 + t.pm, 8u, __ATOMIC_RELAXED, __HIP_MEMORY_SCOPE_AGENT); } }
                }
            }
        } else if (u.kind == K_P) {
            { unsigned* p = cnt2 + (u.pm * 4 + (u.pn & 3)) * 3 + (u.pn >> 4); unsigned sp = 0;
              while (__hip_atomic_load(p, __ATOMIC_RELAXED, __HIP_MEMORY_SCOPE_AGENT) < 8u) { __builtin_amdgcn_s_sleep(2); if (++sp > (1u << 21)) break; }
              if ((u.pn >> 4) == 2) { unsigned* p3 = cnt3 + u.pm; sp = 0;
                  while (__hip_atomic_load(p3, __ATOMIC_RELAXED, __HIP_MEMORY_SCOPE_AGENT) < 96u) { __builtin_amdgcn_s_sleep(2); if (++sp > (1u << 21)) break; } }
              asm volatile("s_waitcnt vmcnt(0)" ::: "memory"); }
            ep(acc, u, wr, wc, fr, fq);
            if ((u.pn >> 4) == 2) {
                asm volatile("s_waitcnt vmcnt(0)" ::: "memory");
                if ((threadIdx.x & 63) == 0) (void)__hip_atomic_fetch_add(cnt + u.pm, 1u, __ATOMIC_RELAXED, __HIP_MEMORY_SCOPE_AGENT);
            }
        } else eo(acc, u, wr, wc, fr, fq);
    }
};

__device__ __forceinline__ int srcmap1(int n) {
    if (n < 1280) return n;
    if (n < 3328) { const int t = (n - 1280) >> 8, cl = (n - 1280) & 255, bj = cl >> 7, ch = 128 * (t & 3) + (cl & 127);
        return (t < 4 ? (bj ? 2816 : 1280) : (bj ? 2304 : 1792)) + ch; }
    return 3840 + (n - 4352);
}
__device__ __forceinline__ void transpose_item(const float* W, int N, int srccol, int k0, bf16_t* WT, int n0, int coff, LAS float* scr, int lane) {
#pragma unroll 8
    for (int i = 0; i < 32; ++i) { const int kk = 2 * i + (lane >> 5); scr[kk * 33 + (lane & 31)] = W[(size_t)(k0 + kk) * N + srccol]; }
    asm volatile("s_waitcnt lgkmcnt(0)" ::: "memory");
    const int c = lane & 7;
#pragma unroll
    for (int j = 0; j < 4; ++j) { const int n = (lane >> 3) + 8 * j; const LAS float* s = scr + (8 * c) * 33 + n;
        u32x4 o; o.x = pk2(s[0 * 33], s[1 * 33]); o.y = pk2(s[2 * 33], s[3 * 33]); o.z = pk2(s[4 * 33], s[5 * 33]); o.w = pk2(s[6 * 33], s[7 * 33]);
        *(u32x4*)(WT + (size_t)(n0 + n) * 1024 + coff + k0 + 8 * c) = o; }
    asm volatile("s_waitcnt lgkmcnt(0)" ::: "memory");
}

__device__ __forceinline__ void phase0(const Args& a, LAS unsigned char* lds, int G, int c) {
    int tid = threadIdx.x; asm volatile("" : "+v"(tid));
    const int lane = tid & 63, wave = tid >> 6;
    size_t z0 = 0; asm volatile("" : "+s"(z0)); unsigned char* ws = a.ws + z0;
#ifdef TEST_ZEROWS
    { u32x4* zp = (u32x4*)(ws + WS_SCR); const size_t nz = (WS_END - WS_SCR) / 16; const u32x4 zz = {0u, 0u, 0u, 0u};
      for (size_t e = (size_t)c * 512 + tid; e < nz; e += (size_t)G * 512) zp[e] = zz; }
#endif
    { bf16_t* FM = (bf16_t*)(ws + WS_FMAT);
      for (int e = c * 512 + tid; e < 32768; e += G * 512) {
          float val;
          if (e < 16384) { const int rho = e >> 7, k = e & 127, k1 = rho & 63, s1 = k & 63; const float fr = (float)((k1 * s1) & 63) * (1.f / 64.f);
              const float cs = __builtin_amdgcn_cosf(fr), sn = __builtin_amdgcn_sinf(fr); val = rho < 64 ? (k < 64 ? cs : sn) : (k < 64 ? -sn : cs); }
          else if (e < 24576) { const int e2 = e - 16384, k2 = e2 >> 7, k = e2 & 127, s2 = k & 63; const float fr = (float)((k2 * s2) & 63) * (1.f / 64.f);
              val = k < 64 ? __builtin_amdgcn_cosf(fr) : __builtin_amdgcn_sinf(fr); }
          else { const int e2 = e - 24576, rho = e2 >> 7, k = e2 & 127, r = k & 63, k1l = rho >> 2, k2 = rho & 3, k1r = r >> 2, s2 = r & 3; const float fr = (float)((k2 * s2) & 3) * 0.25f;
              val = (k1l == k1r) ? (k < 64 ? __builtin_amdgcn_cosf(fr) : __builtin_amdgcn_sinf(fr)) : 0.f; }
          FM[e] = (bf16_t)f2bf(val);
      } }
    { u32x4* ck = (u32x4*)(ws + WS_CK); u32x4* cv = (u32x4*)(ws + WS_CV);
      for (int e = c * 512 + tid; e < 2 * 131072; e += G * 512) {
          const int which = e >= 131072, i = e & 131071; const float* src = (which ? a.cache_v : a.cache_k) + (size_t)i * 8;
          const f32x4 v0 = *(const f32x4*)src, v1 = *(const f32x4*)(src + 4);
          u32x4 o; o.x = pk2(v0[0], v0[1]); o.y = pk2(v0[2], v0[3]); o.z = pk2(v1[0], v1[1]); o.w = pk2(v1[2], v1[3]);
          (which ? cv : ck)[i] = o; } }
    if (c < 96) {
        LAS float* sl = (LAS float*)lds; LAS float* red = (LAS float*)(lds + 36864);
        for (int e = tid; e < 9216; e += 512) { const int j = e >> 10, k = e & 1023; const float v = (j == 0) ? a.c_ctx[k] : a.c[(j - 1) * 1024 + k]; sl[e] = v / (1.0f + expf(-v)); }
        __syncthreads();
        const int l = c / 48, cb = c % 48, col = cb * 64 + (tid & 63), kq = tid >> 6;
        float acc[9];
#pragma unroll
        for (int j = 0; j < 9; ++j) acc[j] = 0.f;
        const float* wp = a.w_mod + ((size_t)l * 1024 + kq * 128) * 3072 + col;
        for (int k = 0; k < 128; k += 16) { float w[16];
#pragma unroll
            for (int u = 0; u < 16; ++u) w[u] = wp[(size_t)(k + u) * 3072];
#pragma unroll
            for (int u = 0; u < 16; ++u)
#pragma unroll
                for (int j = 0; j < 9; ++j) acc[j] += sl[j * 1024 + kq * 128 + k + u] * w[u]; }
#pragma unroll
        for (int j = 0; j < 9; ++j) red[(kq * 9 + j) * 64 + (tid & 63)] = acc[j];
        __syncthreads();
        float* MOD = (float*)(ws + WS_MOD);
        for (int e = tid; e < 576; e += 512) { const int j = e >> 6, cl = e & 63; float s = 0.f;
#pragma unroll
            for (int q = 0; q < 8; ++q) s += red[(q * 9 + j) * 64 + cl];
            MOD[(size_t)(l * 9 + j) * 3072 + cb * 64 + cl] = s + a.b_mod[l * 3072 + cb * 64 + cl]; }
    }
    for (int item = c; item < 256; item += G) {
        const int l = item >> 7, g = (item >> 5) & 3, kb = item & 31, k0 = kb * 32;
        LAS float* Wt = (LAS float*)lds; LAS float* tabc = (LAS float*)(lds + 16384); LAS float* tabs = (LAS float*)(lds + 16384 + 512);
        __syncthreads();
        for (int e = tid; e < 4096; e += 512) { const int kk = e >> 7, cc = e & 127; Wt[e] = a.w_in[((size_t)l * 1024 + k0 + kk) * INW + 3328 + g * 128 + cc]; }
        if (tid < 128) { const float fr = (float)tid * (1.f / 128.f); tabc[tid] = __builtin_amdgcn_cosf(fr); tabs[tid] = __builtin_amdgcn_sinf(fr); }
        __syncthreads();
        const int nl = tid & 255, part = nl >> 7, m = nl & 127, kh = tid >> 8;
        float o[16];
#pragma unroll
        for (int kk = 0; kk < 16; ++kk) o[kk] = 0.f;
        for (int cc = 0; cc < 128; ++cc) { const int ix = (m * cc) & 127; const float tv = part ? -tabs[ix] : tabc[ix];
#pragma unroll
            for (int kk = 0; kk < 16; ++kk) o[kk] += Wt[(16 * kh + kk) * 128 + cc] * tv; }
        bf16_t* dst = (bf16_t*)(ws + WS_BT1 + (size_t)l * BT1_L) + (size_t)(3328 + part * 512 + g * 128 + m) * 1024 + k0 + 16 * kh;
        u32x4 w0, w1; w0.x = pk2(o[0], o[1]); w0.y = pk2(o[2], o[3]); w0.z = pk2(o[4], o[5]); w0.w = pk2(o[6], o[7]);
        w1.x = pk2(o[8], o[9]); w1.y = pk2(o[10], o[11]); w1.z = pk2(o[12], o[13]); w1.w = pk2(o[14], o[15]);
        *(u32x4*)dst = w0; *(u32x4*)(dst + 8) = w1;
    }
    __syncthreads();
    { LAS float* scr = (LAS float*)(lds + wave * 16384);
      const int gw = c * 8 + wave, NGW = G * 8;
      for (int it = gw; it < 2 * 4736; it += NGW) {
          const int l = it / 4736; int r = it - l * 4736;
          if (r < 1920) { const int nb = r >> 4, kb = r & 15, n0 = nb < 104 ? nb * 32 : 4352 + (nb - 104) * 32;
              transpose_item(a.w_in + (size_t)l * 1024 * INW, INW, srcmap1(n0 + (lane & 31)), kb * 64, (bf16_t*)(ws + WS_BT1 + (size_t)l * BT1_L), n0, 0, scr, lane); continue; }
          r -= 1920;
          if (r < 1536) { const int nb = r >> 4, kb = r & 15, n0 = nb * 32;
              transpose_item(a.w_in + (size_t)l * 1024 * INW, INW, 4352 + n0 + (lane & 31), kb * 64, (bf16_t*)(ws + WS_BT1G + (size_t)l * BT1G_L), n0, 0, scr, lane); continue; }
          r -= 1536;
          if (r < 768) { const int b = r >> 8, rr = r & 255, nb = rr >> 3, kb = rr & 7, n0 = nb * 32;
              bf16_t* dst = (bf16_t*)(ws + (b == 1 ? WS_BT2B : WS_BT2AC) + (size_t)l * BT2_L);
              transpose_item(a.w_branch + (size_t)(l * 3 + b) * 512 * 1024, 1024, n0 + (lane & 31), kb * 64, dst, n0, b == 2 ? 512 : 0, scr, lane); continue; }
          r -= 768;
          { const int nb = r >> 4, kb = r & 15, n0 = nb * 32;
              transpose_item(a.w_o + (size_t)l * 1024 * 1024, 1024, n0 + (lane & 31), kb * 64, (bf16_t*)(ws + WS_BT3 + (size_t)l * BT2_L), n0, 0, scr, lane); }
      } }
}

__device__ __forceinline__ void ln_phase(const Args& a, int mode, int layer, int G, int c) {
    int tid = threadIdx.x; asm volatile("" : "+v"(tid));
    const int lane = tid & 63, wave = tid >> 6;
    const float* MOD = (const float*)(a.ws + WS_MOD);
    bf16_t* H = (bf16_t*)(a.ws + WS_H);
    f32x4 nv[4];
    { const int m = c * 8 + wave;
      if (m < TT) { const float* src = mode == 0 ? (m < TP ? a.x_prompt + (size_t)m * DM : a.x_sample + (size_t)(m - TP) * DM) : a.out + (size_t)m * DM;
#pragma unroll
          for (int j = 0; j < 4; ++j) nv[j] = __builtin_nontemporal_load((const f32x4*)(src + 4 * lane + 256 * j)); } }
    for (int m = c * 8 + wave; m < TT; m += G * 8) {
        f32x4 v[4]; float s = 0.f;
#pragma unroll
        for (int j = 0; j < 4; ++j) { v[j] = nv[j]; s += (v[j][0] + v[j][1]) + (v[j][2] + v[j][3]); }
        { const int m2 = m + G * 8;
          if (m2 < TT) { const float* src2 = mode == 0 ? (m2 < TP ? a.x_prompt + (size_t)m2 * DM : a.x_sample + (size_t)(m2 - TP) * DM) : a.out + (size_t)m2 * DM;
#pragma unroll
              for (int j = 0; j < 4; ++j) nv[j] = __builtin_nontemporal_load((const f32x4*)(src2 + 4 * lane + 256 * j)); } }
        float mean = wave_sum(s) * (1.f / DM), s2 = 0.f;
#pragma unroll
        for (int j = 0; j < 4; ++j) { v[j] = v[j] - mean; s2 += (v[j][0] * v[j][0] + v[j][1] * v[j][1]) + (v[j][2] * v[j][2] + v[j][3] * v[j][3]); }
        float rstd = 1.0f / sqrtf(wave_sum(s2) * (1.f / DM) + 1e-6f);
        bool make_h = true; int hl = 0;
        if (mode == 1) {
            float* dst = a.out + (size_t)m * DM; s = 0.f;
#pragma unroll
            for (int j = 0; j < 4; ++j) { const f32x4 g = *(const f32x4*)(a.ln_g + layer * DM + 4 * lane + 256 * j), b = *(const f32x4*)(a.ln_b + layer * DM + 4 * lane + 256 * j);
                v[j] = v[j] * rstd * g + b; if (layer == 1) __builtin_nontemporal_store(v[j], (f32x4*)(dst + 4 * lane + 256 * j)); else *(f32x4*)(dst + 4 * lane + 256 * j) = v[j]; s += (v[j][0] + v[j][1]) + (v[j][2] + v[j][3]); }
            make_h = (layer == 0); hl = 1;
            if (make_h) { mean = wave_sum(s) * (1.f / DM); s2 = 0.f;
#pragma unroll
                for (int j = 0; j < 4; ++j) { v[j] = v[j] - mean; s2 += (v[j][0] * v[j][0] + v[j][1] * v[j][1]) + (v[j][2] * v[j][2] + v[j][3] * v[j][3]); }
                rstd = 1.0f / sqrtf(wave_sum(s2) * (1.f / DM) + 1e-6f); }
        }
        if (make_h) {
            const float* mp = MOD + (size_t)(hl * 9 + cond_of_row(m)) * 3072;
#pragma unroll
            for (int j = 0; j < 4; ++j) { const f32x4 sh = *(const f32x4*)(mp + 4 * lane + 256 * j), sc = *(const f32x4*)(mp + 1024 + 4 * lane + 256 * j);
                const f32x4 h = v[j] * rstd * (sc + 1.0f) + sh; u32x2 w; w.x = pk2(h[0], h[1]); w.y = pk2(h[2], h[3]);
                *(u32x2*)(H + (size_t)m * DM + 4 * lane + 256 * j) = w; }
        }
    }
}

__device__ __forceinline__ void conv_phase(const Args& a, int layer, int G, int c) {
    bf16_t* B2 = (bf16_t*)(a.ws + WS_BUF2);
    const float* cw = a.conv_w + (size_t)layer * 3 * 512;
    int tid = threadIdx.x; asm volatile("" : "+v"(tid));
    const int stride = G * 512;
    for (int e0 = c * 512 + tid; e0 < TT * 64; e0 += 2 * stride) {
        u32x4 u0[2], u1[2], u2[2], w[2]; int mm[2], cc[2]; bool ok[2];
#pragma unroll
        for (int k = 0; k < 2; ++k) {
            const int e = e0 + k * stride; ok[k] = e < TT * 64; const int ee = ok[k] ? e : e0;
            const int m = ee >> 6, ch = (ee & 63) * 8; mm[k] = m; cc[k] = ch;
            const int s = m < TP ? (m & 255) : ((m - TP) & 4095), S = m < TP ? 256 : 4096;
            const u32x4 zero = {0u, 0u, 0u, 0u};
            u1[k] = *(const u32x4*)(B2 + (size_t)m * 1024 + 512 + ch);
            u0[k] = s > 0 ? *(const u32x4*)(B2 + (size_t)(m - 1) * 1024 + 512 + ch) : zero;
            u2[k] = s < S - 1 ? *(const u32x4*)(B2 + (size_t)(m + 1) * 1024 + 512 + ch) : zero;
            w[k] = __builtin_nontemporal_load((const u32x4*)(B2 + (size_t)m * 1024 + ch));
        }
#pragma unroll
        for (int k = 0; k < 2; ++k) {
            const int ch = cc[k];
            float y[8];
#pragma unroll
            for (int i = 0; i < 4; ++i) {
                const float c0a = cw[ch + 2 * i], c0b = cw[ch + 2 * i + 1], c1a = cw[512 + ch + 2 * i], c1b = cw[512 + ch + 2 * i + 1], c2a = cw[1024 + ch + 2 * i], c2b = cw[1024 + ch + 2 * i + 1];
                y[2 * i] = bflo(w[k][i]) * (c0a * bflo(u0[k][i]) + c1a * bflo(u1[k][i]) + c2a * bflo(u2[k][i]));
                y[2 * i + 1] = bfhi(w[k][i]) * (c0b * bfhi(u0[k][i]) + c1b * bfhi(u1[k][i]) + c2b * bfhi(u2[k][i]));
            }
            u32x4 o; o.x = pk2(y[0], y[1]); o.y = pk2(y[2], y[3]); o.z = pk2(y[4], y[5]); o.w = pk2(y[6], y[7]);
            if (ok[k]) *(u32x4*)(B2 + (size_t)mm[k] * 1024 + ch) = o;
        }
    }
}

constexpr int FP = 136;
constexpr int FTP = 264;
typedef short v4i16_t __attribute__((ext_vector_type(4)));
__device__ __forceinline__ void fft_phase(const Args& a, LAS unsigned char* lds, int stage, int G, int c, unsigned* cntf) {
    int tid = threadIdx.x; asm volatile("" : "+v"(tid));
    const int wave = __builtin_amdgcn_readfirstlane(tid >> 6), lane = tid & 63, cq = lane & 15, qq = lane >> 4;
    bf16_t* Z = (bf16_t*)(a.ws + WS_Z); bf16_t* B1 = (bf16_t*)(a.ws + WS_BUF1);
    const bf16_t* FM = (const bf16_t*)(a.ws + WS_FMAT);
    LAS bf16_t* F0 = (LAS bf16_t*)lds;
    LAS bf16_t* DT = (LAS bf16_t*)(lds + 128 * FP * 2);
    __syncthreads();
    { const bf16_t* src = FM + (stage == 0 ? 0 : 16384);
      for (int e = tid; e < 2048; e += 512) { const int row = e >> 4, ch = e & 15; *(LAS u32x4*)(F0 + row * FP + ch * 8) = *(const u32x4*)(src + row * 128 + ch * 8); } }
    u32x4 rg[8];
#define FFT_DECODE(LL, lat_, base_, os_, cs_, jb_, oabs0_) do { lat_ = (LL) < 1024; oabs0_ = 0; \
        if (lat_) { const int b_ = (LL) >> 7, blk_ = ((LL) >> 3) & 15; jb_ = (LL) & 7; \
            if (stage == 0) { base_ = TP + b_ * 4096 + 4 * blk_; os_ = 1; cs_ = 64; oabs0_ = 4 * blk_; } else { base_ = TP + b_ * 4096 + 256 * blk_; os_ = 64; cs_ = 1; oabs0_ = 4 * blk_; } } \
        else { const int Lc_ = (LL) - 1024, b_ = Lc_ >> 3; jb_ = Lc_ & 7; \
            if (stage == 0) { base_ = b_ * 256; os_ = 1; cs_ = 4; } else { base_ = b_ * 256; os_ = 64; cs_ = 1; } } } while (0)
#define FFT_LOAD(base_, os_, cs_, jb_) do { const int c8_ = tid & 7, r_ = tid >> 3; \
        _Pragma("unroll") for (int i = 0; i < 8; ++i) { const int part = i & 1, o = i >> 1; \
            rg[i] = *(const u32x4*)(Z + (size_t)((base_) + o * (os_) + r_ * (cs_)) * 1024 + part * 512 + (jb_) * 64 + 8 * c8_); } } while (0)
#define FFT_WAIT(LL) do { if (stage == 1) { const int i_ = (LL) < 1024 ? (((LL) >> 7) * 8 + ((LL) & 7)) : 64 + ((LL) - 1024); const unsigned tg_ = (LL) < 1024 ? 16u : 1u; unsigned sp_ = 0; \
        while (__hip_atomic_load(cntf + i_, __ATOMIC_RELAXED, __HIP_MEMORY_SCOPE_AGENT) < tg_) { __builtin_amdgcn_s_sleep(2); if (++sp_ > (1u << 21)) break; } \
        asm volatile("s_waitcnt vmcnt(0)" ::: "memory"); } } while (0)
    { bool lat0; int b0, o0, c0, j0, a0; if (c < 1152) { FFT_WAIT(c); FFT_DECODE(c, lat0, b0, o0, c0, j0, a0); FFT_LOAD(b0, o0, c0, j0); } }
    for (int it = 0;; ++it) {
        const int L = it * G + c; if (L >= 1152) break;
        bool lat; int base, os, cs, jb, oabs0;
        FFT_DECODE(L, lat, base, os, cs, jb, oabs0);
        __syncthreads();
        { const int c8 = tid & 7, r = tid >> 3;
#pragma unroll
          for (int i = 0; i < 8; ++i) { const int part = i & 1, o = i >> 1;
              *(LAS u32x4*)(DT + (part * 64 + r) * FTP + o * 64 + 8 * c8) = rg[i]; } }
        __syncthreads();
        { const int L2 = L + G; if (L2 < 1152) { bool lat2; int b2_, o2_, c2_, j2_, a2_; FFT_WAIT(L2); FFT_DECODE(L2, lat2, b2_, o2_, c2_, j2_, a2_); FFT_LOAD(b2_, o2_, c2_, j2_); } }
        bf16x8 bfr[2][4];
#pragma unroll
        for (int nt = 0; nt < 2; ++nt) { const int col = 32 * wave + 16 * nt + cq;
#pragma unroll
            for (int ks = 0; ks < 4; ++ks) {
                const LAS bf16_t* p0 = DT + (32 * ks + 8 * qq + (cq >> 2)) * FTP + (col - cq) + 4 * (cq & 3);
                const v4i16_t t0 = __builtin_amdgcn_ds_read_tr16_b64_v4i16((LAS v4i16_t*)p0), t1 = __builtin_amdgcn_ds_read_tr16_b64_v4i16((LAS v4i16_t*)(p0 + 4 * FTP));
                bfr[nt][ks] = (bf16x8){t0[0], t0[1], t0[2], t0[3], t1[0], t1[1], t1[2], t1[3]}; } }
        const int o = wave >> 1;
        const int jj0 = 32 * (wave & 1) + cq;
        if (stage == 0) {
            f32x4 acc[8][2];
#pragma unroll
            for (int mt = 0; mt < 8; ++mt) { acc[mt][0] = (f32x4){0.f, 0.f, 0.f, 0.f}; acc[mt][1] = (f32x4){0.f, 0.f, 0.f, 0.f};
#pragma unroll
                for (int ks = 0; ks < 4; ++ks) { const bf16x8 af = *(const LAS bf16x8*)(F0 + (16 * mt + cq) * FP + 32 * ks + 8 * qq);
                    acc[mt][0] = __builtin_amdgcn_mfma_f32_16x16x32_bf16(af, bfr[0][ks], acc[mt][0], 0, 0, 0);
                    acc[mt][1] = __builtin_amdgcn_mfma_f32_16x16x32_bf16(af, bfr[1][ks], acc[mt][1], 0, 0, 0); } }
            const int s2abs = lat ? (oabs0 + o) : o; const int ntw_mask = lat ? 4095 : 255; const float ntw_inv = lat ? (1.f / 4096.f) : (1.f / 256.f);
            __syncthreads();
#pragma unroll
            for (int mt = 0; mt < 4; ++mt)
#pragma unroll
                for (int i = 0; i < 4; ++i) { const int k1 = 16 * mt + 4 * qq + i; const float fr = (float)((k1 * s2abs) & ntw_mask) * ntw_inv;
                    const float cs_ = __builtin_amdgcn_cosf(fr), sn_ = __builtin_amdgcn_sinf(fr);
                    LAS bf16_t* orow = DT + (o * 64 + k1) * FP + jj0;
#pragma unroll
                    for (int nt = 0; nt < 2; ++nt) { const float xr = acc[mt][nt][i], xi = acc[mt + 4][nt][i];
                        orow[16 * nt] = (bf16_t)f2bf(xr * cs_ + xi * sn_); orow[64 + 16 * nt] = (bf16_t)f2bf(xi * cs_ - xr * sn_); } }
            __syncthreads();
#pragma unroll
            for (int i = 0; i < 8; ++i) { const int id = tid + 512 * i, row = id >> 4, part = (id >> 3) & 1, ch = id & 7;
                const u32x4 v = *(const LAS u32x4*)(DT + row * FP + part * 64 + ch * 8);
                *(u32x4*)(Z + (size_t)(base + (row >> 6) * os + (row & 63) * cs) * 1024 + part * 512 + jb * 64 + ch * 8) = v; }
        } else {
            const LAS bf16_t* FB = lat ? F0 : F0 + 64 * FP;
            f32x4 acc[4][2];
#pragma unroll
            for (int mt = 0; mt < 4; ++mt) { acc[mt][0] = (f32x4){0.f, 0.f, 0.f, 0.f}; acc[mt][1] = (f32x4){0.f, 0.f, 0.f, 0.f};
#pragma unroll
                for (int ks = 0; ks < 4; ++ks) { const bf16x8 af = *(const LAS bf16x8*)(FB + (16 * mt + cq) * FP + 32 * ks + 8 * qq);
                    acc[mt][0] = __builtin_amdgcn_mfma_f32_16x16x32_bf16(af, bfr[0][ks], acc[mt][0], 0, 0, 0);
                    acc[mt][1] = __builtin_amdgcn_mfma_f32_16x16x32_bf16(af, bfr[1][ks], acc[mt][1], 0, 0, 0); } }
            const float nrm = lat ? 0.00138106793f   : 0.00552427173f  ;
            __syncthreads();
            LAS float* OT = (LAS float*)DT;
#pragma unroll
            for (int mt = 0; mt < 4; ++mt)
#pragma unroll
                for (int i = 0; i < 4; ++i) { const int rho = 16 * mt + 4 * qq + i;
#pragma unroll
                    for (int nt = 0; nt < 2; ++nt) OT[(o * 64 + rho) * 68 + jj0 + 16 * nt] = acc[mt][nt][i] * nrm; }
            __syncthreads();
#pragma unroll
            for (int i = 0; i < 4; ++i) { const int id = tid + 512 * i, row = id >> 3, ch = id & 7, oo = row >> 6, rho = row & 63;
                const int orow_i = lat ? (base - 256 * (oabs0 >> 2) + oabs0 + oo + 64 * rho) : (base + 16 * oo + (rho >> 2) + 64 * (rho & 3));
                const f32x4 v0 = *(const LAS f32x4*)(OT + row * 68 + ch * 8), v1 = *(const LAS f32x4*)(OT + row * 68 + ch * 8 + 4);
                bf16_t* gp = B1 + (size_t)orow_i * 1024 + 512 + jb * 64 + ch * 8;
                const u32x4 g = *(const u32x4*)gp;
                u32x4 w; w.x = pk2(v0[0] * bflo(g.x), v0[1] * bfhi(g.x)); w.y = pk2(v0[2] * bflo(g.y), v0[3] * bfhi(g.y)); w.z = pk2(v1[0] * bflo(g.z), v1[1] * bfhi(g.z)); w.w = pk2(v1[2] * bflo(g.w), v1[3] * bfhi(g.w));
                *(u32x4*)gp = w; }
        }
    }
    __syncthreads();
    if (stage == 0) {
        asm volatile("s_waitcnt vmcnt(0)" ::: "memory");
        __syncthreads();
        if (tid < 64) { __builtin_amdgcn_fence(__ATOMIC_RELEASE, "agent"); asm volatile("s_waitcnt vmcnt(0)" ::: "memory");
            if (tid == 0) for (int it = 0;; ++it) { const int L = it * G + c; if (L >= 1152) break;
                (void)__hip_atomic_fetch_add(cntf + (L < 1024 ? ((L >> 7) * 8 + (L & 7)) : 64 + (L - 1024)), 1u, __ATOMIC_RELAXED, __HIP_MEMORY_SCOPE_AGENT); } }
        __syncthreads();
    }
}

constexpr int AKP = 72;
__device__ __forceinline__ void attn_phase(const Args& a, LAS unsigned char* lds, int layer, int G, int c) {
    int tid = threadIdx.x; asm volatile("" : "+v"(tid));
    const int wave = __builtin_amdgcn_readfirstlane(tid >> 6), lane = tid & 63, cq = lane & 15, qq = lane >> 4;
    const bf16_t* Q = (const bf16_t*)(a.ws + WS_Q); const bf16_t* KV = (const bf16_t*)(a.ws + WS_KV);
    const bf16_t* CK = (const bf16_t*)(a.ws + WS_CK); const bf16_t* CV = (const bf16_t*)(a.ws + WS_CV);
    bf16_t* B1 = (bf16_t*)(a.ws + WS_BUF1);
    LAS bf16_t* KS = (LAS bf16_t*)lds;
    LAS bf16_t* VT = (LAS bf16_t*)(lds + 2 * 64 * AKP * 2);
    const int g = wave >> 1, th = wave & 1;
    const int lkey = tid >> 3, ldc = tid & 7;
    __syncthreads();
    for (int it = 0;; ++it) {
        const int L = it * G + (G - 1 - c); if (L >= 1152) break;
        const bool lat = L < 1024;
        int rowbase, t0, kvh, kstart, nband, ntile, cbase;
        if (lat) { const int b = L >> 7; kvh = (L >> 6) & 1; const int qb = L & 63; rowbase = TP + b * 4096; t0 = qb * 64;
            kstart = t0 - 128 < 0 ? 0 : t0 - 128; const int kend = t0 + 192 > 4096 ? 4096 : t0 + 192; nband = (kend - kstart) >> 6; ntile = nband + 8; cbase = (b * 2 + layer) * 512; }
        else { const int Lc = L - 1024, b = Lc >> 3; kvh = (Lc >> 2) & 1; const int qb = Lc & 3; rowbase = b * 256; t0 = qb * 64; kstart = 0; nband = 4; ntile = 4; cbase = 0; }
        const int h = kvh * 4 + g;
        const float sk = a.sink[layer * 8 + h] * 1.4426950408889634f;
        bf16x8 qf[2][2];
#pragma unroll
        for (int qt = 0; qt < 2; ++qt)
#pragma unroll
            for (int ks = 0; ks < 2; ++ks) qf[qt][ks] = *(const bf16x8*)(Q + (size_t)(rowbase + t0 + 32 * th + 16 * qt + cq) * 512 + h * 64 + 32 * ks + 8 * qq);
        f32x4 o[4][2];
#pragma unroll
        for (int dt = 0; dt < 4; ++dt) { o[dt][0] = (f32x4){0.f, 0.f, 0.f, 0.f}; o[dt][1] = (f32x4){0.f, 0.f, 0.f, 0.f}; }
        float mrun[2] = {sk, sk}, lrun[2] = {qq == 0 ? 1.f : 0.f, qq == 0 ? 1.f : 0.f};
        u32x4 kr, vr;
#define ATT_LOAD(i) do { if ((i) < nband) { const bf16_t* p = KV + (size_t)(rowbase + kstart + 64 * (i) + lkey) * 256 + kvh * 64 + 8 * ldc; kr = *(const u32x4*)p; vr = *(const u32x4*)(p + 128); } \
            else { const size_t off = (size_t)(cbase + 64 * ((i) - nband) + lkey) * 128 + kvh * 64 + 8 * ldc; kr = *(const u32x4*)(CK + off); vr = *(const u32x4*)(CV + off); } } while (0)
#define ATT_STORE(buf) do { *(LAS u32x4*)(KS + (buf) * 64 * AKP + lkey * AKP + 8 * ldc) = kr; \
            *(LAS u32x4*)(VT + (buf) * 64 * AKP + lkey * AKP + 8 * ldc) = vr; } while (0)
        ATT_LOAD(0);
        ATT_STORE(0);
        __syncthreads();
        for (int i = 0; i < ntile; ++i) {
            const int buf = i & 1;
            if (i + 1 < ntile) ATT_LOAD(i + 1);
            const LAS bf16_t* ks_ = KS + buf * 64 * AKP; const LAS bf16_t* vt_ = VT + buf * 64 * AKP;
            f32x4 s[4][2];
#pragma unroll
            for (int kt = 0; kt < 4; ++kt) { s[kt][0] = (f32x4){0.f, 0.f, 0.f, 0.f}; s[kt][1] = (f32x4){0.f, 0.f, 0.f, 0.f};
#pragma unroll
                for (int ks = 0; ks < 2; ++ks) { const bf16x8 kf = *(const LAS bf16x8*)(ks_ + (16 * kt + cq) * AKP + 32 * ks + 8 * qq);
                    s[kt][0] = __builtin_amdgcn_mfma_f32_16x16x32_bf16(kf, qf[0][ks], s[kt][0], 0, 0, 0);
                    s[kt][1] = __builtin_amdgcn_mfma_f32_16x16x32_bf16(kf, qf[1][ks], s[kt][1], 0, 0, 0); } }
            if (lat && i < nband && (kstart + 64 * i < t0 - 64 || kstart + 64 * i > t0 + 64)) {
                const int tkb = kstart + 64 * i + 4 * qq;
#pragma unroll
                for (int qt = 0; qt < 2; ++qt) { const int tq = t0 + 32 * th + 16 * qt + cq;
#pragma unroll
                    for (int kt = 0; kt < 4; ++kt)
#pragma unroll
                        for (int e = 0; e < 4; ++e) { const int d = tq - (tkb + 16 * kt + e); if (d > 128 || d < -128) s[kt][qt][e] = -1e30f; } }
            }
            bf16x8 pf[2][2];
#pragma unroll
            for (int qt = 0; qt < 2; ++qt) {
                float mx = s[0][qt][0];
#pragma unroll
                for (int kt = 0; kt < 4; ++kt)
#pragma unroll
                    for (int e = 0; e < 4; ++e) mx = fmaxf(mx, s[kt][qt][e]);
                mx = fmaxf(mx, __shfl_xor(mx, 16)); mx = fmaxf(mx, __shfl_xor(mx, 32));
                const float mn = fmaxf(mrun[qt], mx), al = __builtin_amdgcn_exp2f(mrun[qt] - mn);
                mrun[qt] = mn; float ls = 0.f;
                float p[4][4];
#pragma unroll
                for (int kt = 0; kt < 4; ++kt)
#pragma unroll
                    for (int e = 0; e < 4; ++e) { p[kt][e] = __builtin_amdgcn_exp2f(s[kt][qt][e] - mn); ls += p[kt][e]; }
                lrun[qt] = lrun[qt] * al + ls;
#pragma unroll
                for (int dt = 0; dt < 4; ++dt) o[dt][qt] = o[dt][qt] * al;
#pragma unroll
                for (int j = 0; j < 2; ++j) { u32x4 w; w.x = cvt_pk(p[2 * j][0], p[2 * j][1]); w.y = cvt_pk(p[2 * j][2], p[2 * j][3]); w.z = cvt_pk(p[2 * j + 1][0], p[2 * j + 1][1]); w.w = cvt_pk(p[2 * j + 1][2], p[2 * j + 1][3]);
                    pf[qt][j] = __builtin_bit_cast(bf16x8, w); }
            }
#pragma unroll
            for (int j = 0; j < 2; ++j)
#pragma unroll
                for (int dt = 0; dt < 4; ++dt) {
                    const LAS bf16_t* vp = vt_ + (32 * j + 4 * qq + (cq >> 2)) * AKP + 16 * dt + 4 * (cq & 3);
                    const v4i16_t t0 = __builtin_amdgcn_ds_read_tr16_b64_v4i16((LAS v4i16_t*)vp), t1 = __builtin_amdgcn_ds_read_tr16_b64_v4i16((LAS v4i16_t*)(vp + 16 * AKP));
                    const bf16x8 vf = (bf16x8){t0[0], t0[1], t0[2], t0[3], t1[0], t1[1], t1[2], t1[3]};
                    o[dt][0] = __builtin_amdgcn_mfma_f32_16x16x32_bf16(vf, pf[0][j], o[dt][0], 0, 0, 0);
                    o[dt][1] = __builtin_amdgcn_mfma_f32_16x16x32_bf16(vf, pf[1][j], o[dt][1], 0, 0, 0); }
            if (i + 1 < ntile) ATT_STORE(buf ^ 1);
            __syncthreads();
        }
#undef ATT_LOAD
#undef ATT_STORE
#pragma unroll
        for (int qt = 0; qt < 2; ++qt) { float lt = lrun[qt]; lt += __shfl_xor(lt, 16); lt += __shfl_xor(lt, 32); const float inv = 1.0f / lt;
            bf16_t* prow = B1 + (size_t)(rowbase + t0 + 32 * th + 16 * qt + cq) * 1024 + h * 64;
#pragma unroll
            for (int k = 0; k < 4; k += 2) {
                float r0[4], r1[4];
#pragma unroll
                for (int e = 0; e < 4; ++e) { const auto r = __builtin_amdgcn_permlane16_swap(__float_as_uint(o[k][qt][e] * inv), __float_as_uint(o[k + 1][qt][e] * inv), false, false);
                    r0[e] = __uint_as_float(r[0]); r1[e] = __uint_as_float(r[1]); }
                bf16_t* p = prow + ((qq & 1) ? 16 * (k + 1) + 4 * (qq - 1) : 16 * k + 4 * qq);
                const u32x4 z = *(const u32x4*)p;
                u32x4 w; w.x = cvt_pk(r0[0] * bflo(z.x), r0[1] * bfhi(z.x)); w.y = cvt_pk(r0[2] * bflo(z.y), r0[3] * bfhi(z.y));
                w.z = cvt_pk(r1[0] * bflo(z.z), r1[1] * bfhi(z.z)); w.w = cvt_pk(r1[2] * bflo(z.w), r1[3] * bfhi(z.w));
                *(u32x4*)p = w; } }
    }
    __syncthreads();
}


#define XB_TMO      128
#define XB_XCNT(j)  (256  + 64 * (j))
#define XB_XSUB(j)  (1280 + 64 * (j))
#define XB_XGEN(j)  (2304 + 64 * (j))
#define XB_TOP      3328
#define XB_TOPGEN   3392
#define XCD_BAR_WORDS 3456
#define XB_SPIN_CAP (1u << 22)
__device__ __forceinline__ unsigned xb_ld(unsigned* p)              { return __hip_atomic_load(p, __ATOMIC_RELAXED, __HIP_MEMORY_SCOPE_AGENT); }
__device__ __forceinline__ unsigned xb_add(unsigned* p, unsigned v) { return __hip_atomic_fetch_add(p, v, __ATOMIC_RELAXED, __HIP_MEMORY_SCOPE_AGENT); }
__device__ __forceinline__ unsigned xb_xcc_id() { return (unsigned)__builtin_amdgcn_s_getreg((3 << 11) | 20) & 0xFu; }
#define XB_SPIN(cond, bar) do { unsigned _sp = 0; while (cond) { __builtin_amdgcn_s_sleep(1); \
    if ((++_sp & 255u) == 0u) { if (xb_ld(&(bar)[XB_TMO])) break; if (_sp > XB_SPIN_CAP) { atomicAdd(&(bar)[XB_TMO], 1u); break; } } } } while (0)
struct XcdBarrier { unsigned* bar; unsigned x; volatile LAS unsigned* st; };
__device__ __forceinline__ XcdBarrier xcd_barrier_post(unsigned* bar, volatile LAS unsigned* st) {
    XcdBarrier b; b.bar = bar; b.x = xb_xcc_id(); b.st = st;
    if (threadIdx.x == 0) (void)xb_add(&bar[XB_XCNT(b.x)], 1u);
    return b;
}
__device__ __forceinline__ void xcd_barrier_complete(unsigned* bar, unsigned x, unsigned& nloc, unsigned& nx) {
    const unsigned G = gridDim.x * gridDim.y * gridDim.z;
    unsigned sum, cnt, mine, sp = 0u;
    for (;;) {
        sum = 0u; cnt = 0u; mine = 0u;
#pragma unroll
        for (unsigned j = 0; j < 16; ++j) { const unsigned c = xb_ld(&bar[XB_XCNT(j)]); sum += c; cnt += (c > 0u) ? 1u : 0u; mine = (j == x) ? c : mine; }
        if (sum == G) break;
        __builtin_amdgcn_s_sleep(1);
        if ((++sp & 255u) == 0u) { if (xb_ld(&bar[XB_TMO])) break; if (sp > XB_SPIN_CAP) { atomicAdd(&bar[XB_TMO], 1u); break; } }
    }
    nloc = mine > 0u ? mine : 1u; nx = cnt > 0u ? cnt : 1u;
}
__device__ __forceinline__ void xcd_barrier(const XcdBarrier& b) {
    asm volatile("s_waitcnt vmcnt(0)" ::: "memory");
    __syncthreads();
    if (threadIdx.x == 0) {
        unsigned* bar = b.bar;
        __builtin_amdgcn_s_waitcnt(0);
        unsigned nloc = b.st[0], nx = b.st[1];
        if (nloc == 0u) { xcd_barrier_complete(bar, b.x, nloc, nx); b.st[0] = nloc; b.st[1] = nx; }
        const unsigned old = xb_add(&bar[XB_XSUB(b.x)], 1u);
        const unsigned gen = old / nloc;
        if (old + 1u == (gen + 1u) * nloc) {
            __builtin_amdgcn_fence(__ATOMIC_RELEASE, "agent");
            asm volatile("s_waitcnt vmcnt(0)" ::: "memory");
            const unsigned og = xb_add(&bar[XB_TOP], 1u);
            const unsigned tg = og / nx;
            if (og + 1u == (tg + 1u) * nx) xb_add(&bar[XB_TOPGEN], 1u);
            else XB_SPIN(xb_ld(&bar[XB_TOPGEN]) == tg, bar);
            __builtin_amdgcn_fence(__ATOMIC_ACQUIRE, "agent");
            xb_add(&bar[XB_XGEN(b.x)], 1u);
            asm volatile("s_waitcnt vmcnt(0)" ::: "memory");
        } else {
            XB_SPIN(xb_ld(&bar[XB_XGEN(b.x)]) == gen, bar);
            __builtin_amdgcn_fence(__ATOMIC_ACQUIRE, "agent");
            asm volatile("s_waitcnt vmcnt(0)" ::: "memory");
        }
    }
    __syncthreads();
}

__global__ void __launch_bounds__(512) mega_fwd(Args a) {
    extern __shared__ __attribute__((aligned(16))) unsigned char lds_raw[];
    LAS unsigned char* lds = (LAS unsigned char*)lds_raw;
    const int G = gridDim.x, c = blockIdx.x;
    unsigned char* ws;
    volatile LAS unsigned* bst = (volatile LAS unsigned*)(lds + LDS_BYTES - 64);
    if (threadIdx.x < 2) bst[threadIdx.x] = 0u;
    __syncthreads();
    XcdBarrier xbar = xcd_barrier_post((unsigned*)(a.ws + WS_BAR), bst);
    for (int ph = a.ph_lo; ph < a.ph_hi; ++ph) {
        if (ph > a.ph_lo) {
            if (a.ph_hi > 1000) {
                cg::this_grid().sync();
            } else {
                xcd_barrier(xbar);
            }
        }
        { size_t z = 0; asm volatile("" : "+s"(z)); ws = a.ws + z; }
#ifndef DBG_MASK
#define DBG_MASK 0xff
#endif
        if (ph == 0) { if (DBG_MASK & 1) phase0(a, lds, G, c); }
        else if (ph == 1) { if (DBG_MASK & 2) ln_phase(a, 0, 0, G, c); }
        else {
            const int l = (ph - 2) / 4, sub = (ph - 2) % 4;
            if (sub == 0) {
                SchedG1 S{(const char*)(ws + WS_H), (const char*)(ws + WS_BT1 + (size_t)l * BT1_L), G, c};
                EpiG1 E{(bf16_t*)(ws + WS_Q), (bf16_t*)(ws + WS_KV), (bf16_t*)(ws + WS_BUF1), (bf16_t*)(ws + WS_BUF2), (bf16_t*)(ws + WS_Z), a.out + OUT_NK, a.out + OUT_NV, l};
                if (DBG_MASK & 4) pg8::gemm_phase<EpiG1, SchedG1>(lds, S, E);
            } else if (sub == 1) {
                unsigned* cntf = (unsigned*)(ws + WS_BAR + 32768) + l * 192;
                conv_phase(a, l, G, c);
                fft_phase(a, lds, 0, G, c, cntf);
                attn_phase(a, lds, l, G, c);
                fft_phase(a, lds, 1, G, c, cntf);
            } else if (sub == 2) {
                unsigned* cntl = (unsigned*)(ws + WS_CNT) + l * 144; unsigned* cnt2l = (unsigned*)(ws + WS_CNT2) + l * 1728;
                SchedPG S{(const char*)(ws + WS_BUF1), (const char*)(ws + WS_BUF2), (const char*)(ws + WS_BT2AC + (size_t)l * BT2_L), (const char*)(ws + WS_BT2B + (size_t)l * BT2_L),
                          (const char*)(ws + WS_MG), (const char*)(ws + WS_BT3 + (size_t)l * BT2_L), cntl, G, c, (const char*)(ws + WS_H), (const char*)(ws + WS_BT1G + (size_t)l * BT1G_L)};
                EpiPG E{EpiP{ws, (bf16_t*)(ws + WS_MG)}, EpiOut{a.x_prompt, a.x_sample, a.out, (const float*)(ws + WS_MOD), l}, cntl, cnt2l, ws, (unsigned*)(ws + WS_CNT + 1152) + l * 144, G, c};
                pg8::gemm_phase<EpiPG, SchedPG>(lds, S, E);
            } else {
                ln_phase(a, 1, l, G, c);
            }
        }
    }
}

extern "C" void kernel_launch(void* const* d_in, const int* in_sizes, int n_in, void* d_out, int out_size, void* d_ws, size_t ws_size, hipStream_t stream) {
    static int grid = 0;
    if (grid == 0) {
        if (n_in != 15 || ws_size < WS_END) { fprintf(stderr, "kernel_launch: unexpected n_in %d / ws_size %zu (need %zu)\n", n_in, ws_size, (size_t)WS_END); grid = -1; return; }
        int dev = 0, cus = 0, per_cu = 0;
        if (hipGetDevice(&dev) != hipSuccess || hipDeviceGetAttribute(&cus, hipDeviceAttributeMultiprocessorCount, dev) != hipSuccess) { grid = -1; return; }
        if (hipFuncSetAttribute((const void*)mega_fwd, hipFuncAttributeMaxDynamicSharedMemorySize, LDS_BYTES) != hipSuccess) { fprintf(stderr, "kernel_launch: hipFuncSetAttribute failed\n"); grid = -1; return; }
        if (hipOccupancyMaxActiveBlocksPerMultiprocessor(&per_cu, (const void*)mega_fwd, 512, LDS_BYTES) != hipSuccess || per_cu < 1) { fprintf(stderr, "kernel_launch: occupancy query says %d\n", per_cu); per_cu = 1; }
        (void)hipGetLastError();
        grid = cus * per_cu; if (grid > 256) grid = 256;
        if (grid != 256) { fprintf(stderr, "kernel_launch: this build needs exactly 256 co-resident workgroups, got %d\n", grid); grid = -1; return; }
    }
    if (grid < 0) return;
    Args a{};
    a.x_prompt = (const float*)d_in[0]; a.x_sample = (const float*)d_in[1]; a.cache_k = (const float*)d_in[2]; a.cache_v = (const float*)d_in[3];
    a.c = (const float*)d_in[4]; a.c_ctx = (const float*)d_in[5]; a.w_mod = (const float*)d_in[6]; a.b_mod = (const float*)d_in[7]; a.w_in = (const float*)d_in[8];
    a.sink = (const float*)d_in[9]; a.conv_w = (const float*)d_in[10]; a.w_branch = (const float*)d_in[11]; a.w_o = (const float*)d_in[12]; a.ln_g = (const float*)d_in[13]; a.ln_b = (const float*)d_in[14];
    a.out = (float*)d_out; a.ws = (unsigned char*)d_ws;
#if MK_MULTI
#ifndef RUN_PHASES
#define RUN_PHASES NPHASE
#endif
    for (int ph = 0; ph < RUN_PHASES; ++ph) { a.ph_lo = ph; a.ph_hi = ph + 1; hipLaunchKernelGGL(mega_fwd, dim3(grid), dim3(512), LDS_BYTES, stream, a); }
#else
    a.ph_lo = 0; a.ph_hi = NPHASE;
    (void)hipMemsetAsync((char*)d_ws + WS_BAR, 0, 32768 + 2048, stream);
    void* args[] = {&a};
    hipError_t e = hipLaunchCooperativeKernel((const void*)mega_fwd, dim3(grid), dim3(512), args, LDS_BYTES, stream);
    if (e != hipSuccess) fprintf(stderr, "cooperative launch failed: %s (grid %d)\n", hipGetErrorString(e), grid);
#endif
}
```
